# Optimizing an MI355X kernel written in HIP

```python
import math
import jax, jax.numpy as jnp
from jax import lax
import numpy as np

D_MODEL = 2048
BATCH = 1
SEQ = 8192
DEPTH = 2

HEAD_DIM = 128
N_MIX_HEADS = D_MODEL // HEAD_DIM
DIFF_HEADS = N_MIX_HEADS // 4
MOBA_HEADS = (N_MIX_HEADS - DIFF_HEADS) // 2
DSA_HEADS = N_MIX_HEADS - DIFF_HEADS - MOBA_HEADS
MOBA_BLOCK = 256
MOBA_TOPK = 3
MOBA_Q_BLOCK = 64
DIFF_QK_DIM = HEAD_DIM // 2
DIFF_V_DIM = HEAD_DIM
DSA_TOPK = 256
IDX_HEADS = 8
IDX_DIM = 64
Q_BLOCK = 128
MEM_LEN = 256
CROSS_HEADS = 4
D_FF = 5504
CONV_WIDTH = 3
ROPE_THETA = 10000.0
RMS_EPS = 1e-6

MOBA_W = MOBA_HEADS * HEAD_DIM
DIFF_QK_W = DIFF_HEADS * 2 * DIFF_QK_DIM
DIFF_V_W = DIFF_HEADS * DIFF_V_DIM
DSA_W = DSA_HEADS * HEAD_DIM
IDX_Q_W = IDX_HEADS * IDX_DIM
D_MIX = MOBA_W + DIFF_V_W + DSA_W
IN_SPLITS = (MOBA_W, MOBA_W, MOBA_W, DIFF_QK_W, DIFF_QK_W, DIFF_V_W,
             DSA_W, DSA_W, DSA_W, IDX_Q_W, IDX_DIM, IDX_HEADS)
D_IN = sum(IN_SPLITS)
CROSS_W = CROSS_HEADS * HEAD_DIM

kernel_name = 'hymba_style_moba_diff_dsa_hybrid'

F32 = jnp.float32


def rms_norm(x, g):
    xf = x.astype(F32)
    y = xf * lax.rsqrt(jnp.mean(xf * xf, axis=-1, keepdims=True) + RMS_EPS)
    return (y * g.astype(F32)).astype(x.dtype)


def rope(x, pos):
    d = x.shape[-1]
    half = d // 2
    inv = ROPE_THETA ** (-(jnp.arange(half, dtype=F32) * 2.0 / d))
    ang = pos.astype(F32)[..., None] * inv
    cos = jnp.cos(ang)[:, :, None, :]
    sin = jnp.sin(ang)[:, :, None, :]
    xf = x.astype(F32)
    x1, x2 = xf[..., :half], xf[..., half:]
    return jnp.concatenate([x1 * cos - x2 * sin, x2 * cos + x1 * sin], axis=-1).astype(x.dtype)


def _split_columns(proj):
    offs, acc = [], 0
    for w in IN_SPLITS[:-1]:
        acc += w
        offs.append(acc)
    return jnp.split(proj, offs, axis=-1)


def _query_block_sweep(fn, block, *arrays):
    b, s = arrays[0].shape[:2]
    n = s // block
    blocked = tuple(a.reshape(b, n, block, *a.shape[2:]).swapaxes(0, 1) for a in arrays)
    out = lax.map(lambda args: fn(args[0], *args[1:]), (jnp.arange(n, dtype=jnp.int32),) + blocked)
    return out.swapaxes(0, 1).reshape(b, s, *out.shape[3:])


def moba_attention(q, k, v):
    b, s, h, d = q.shape
    nb = -(-s // MOBA_BLOCK)
    pad = nb * MOBA_BLOCK - s
    kp = jnp.pad(k, ((0, 0), (0, pad), (0, 0), (0, 0)))
    vp = jnp.pad(v, ((0, 0), (0, pad), (0, 0), (0, 0)))
    kb = kp.reshape(b, nb, MOBA_BLOCK, h, d)
    cnt = jnp.clip(s - jnp.arange(nb) * MOBA_BLOCK, 1, MOBA_BLOCK).astype(F32)
    kbar = kb.astype(F32).sum(axis=2) / cnt[None, :, None, None]
    kb_t = kb.transpose(0, 3, 1, 2, 4)
    vb_t = vp.reshape(b, nb, MOBA_BLOCK, h, d).transpose(0, 3, 1, 2, 4)
    n_sel = max(1, min(MOBA_TOPK, nb - 1))
    n_s = n_sel * MOBA_BLOCK
    scale = d ** -0.5
    bi = jnp.arange(b)[:, None, None, None]
    hi = jnp.arange(h)[None, None, :, None]

    def step(qi, qblk):
        t = qi * MOBA_Q_BLOCK + jnp.arange(MOBA_Q_BLOCK)
        cur = (qi * MOBA_Q_BLOCK) // MOBA_BLOCK
        qf = qblk.astype(F32)
        gate = jnp.einsum('bqhd,bnhd->bqhn', qf, kbar)
        gate = jnp.where(jnp.arange(nb) < cur, gate, -jnp.inf)
        _, sel = lax.top_k(gate, n_sel)
        sel_ok = sel < cur
        ks = kb_t[bi, hi, sel].astype(F32)
        vs = vb_t[bi, hi, sel].astype(F32)
        s_sel = jnp.einsum('bqhd,bqhnkd->bqhnk', qf, ks) * scale
        s_sel = jnp.where(sel_ok[..., None], s_sel, -jnp.inf).reshape(b, MOBA_Q_BLOCK, h, n_s)
        k_own = lax.dynamic_slice_in_dim(kp, cur * MOBA_BLOCK, MOBA_BLOCK, axis=1).astype(F32)
        v_own = lax.dynamic_slice_in_dim(vp, cur * MOBA_BLOCK, MOBA_BLOCK, axis=1).astype(F32)
        s_own = jnp.einsum('bqhd,bkhd->bqhk', qf, k_own) * scale
        causal = (cur * MOBA_BLOCK + jnp.arange(MOBA_BLOCK))[None, :] <= t[:, None]
        s_own = jnp.where(causal[None, :, None, :], s_own, -jnp.inf)
        p = jax.nn.softmax(jnp.concatenate([s_sel, s_own], axis=-1), axis=-1)
        p_sel = p[..., :n_s].reshape(b, MOBA_Q_BLOCK, h, n_sel, MOBA_BLOCK)
        o = (jnp.einsum('bqhnk,bqhnkd->bqhd', p_sel, vs)
             + jnp.einsum('bqhk,bkhd->bqhd', p[..., n_s:], v_own))
        return o.astype(qblk.dtype)

    return _query_block_sweep(step, MOBA_Q_BLOCK, q)


def diff_attention(q, k, v, lam):
    s = q.shape[1]
    scale = q.shape[-1] ** -0.5
    kf = k.astype(F32)
    vf = v.astype(F32)
    kpos = jnp.arange(s)

    def step(qi, qblk):
        t = qi * Q_BLOCK + jnp.arange(Q_BLOCK)
        sc = jnp.einsum('bqhcd,bshcd->bchqs', qblk.astype(F32), kf) * scale
        causal = kpos[None, :] <= t[:, None]
        sc = jnp.where(causal[None, None, None], sc, -jnp.inf)
        p = jax.nn.softmax(sc, axis=-1)
        a = p[:, 0] - lam * p[:, 1]
        return jnp.einsum('bhqs,bshd->bqhd', a, vf).astype(v.dtype)

    return _query_block_sweep(step, Q_BLOCK, q)


def dsa_attention(q, k, v, q_idx, k_idx, w_idx):
    b, s, h, d = q.shape
    n_keep = min(DSA_TOPK, s // 4)
    scale = d ** -0.5
    idx_scale = q_idx.shape[-1] ** -0.5
    kidx_f = k_idx.astype(F32)
    kpos = jnp.arange(s)
    bi = jnp.arange(b)[:, None, None]

    def step(qi, qblk, qiblk, wblk):
        t = qi * Q_BLOCK + jnp.arange(Q_BLOCK)
        rel = jax.nn.relu(jnp.einsum('bqhd,bsd->bqhs', qiblk.astype(F32), kidx_f) * idx_scale)
        score = jnp.einsum('bqhs,bqh->bqs', rel, wblk.astype(F32))
        admissible = kpos[None, :] <= t[:, None]
        score = jnp.where(admissible[None], score, -jnp.inf)
        _, sel = lax.top_k(score, n_keep)
        sel_ok = sel <= t[None, :, None]
        ks = k[bi, sel].astype(F32)
        vs = v[bi, sel].astype(F32)
        logits = jnp.einsum('bqhd,bqkhd->bqhk', qblk.astype(F32), ks) * scale
        logits = jnp.where(sel_ok[:, :, None, :], logits, -jnp.inf)
        p = jax.nn.softmax(logits, axis=-1)
        return jnp.einsum('bqhk,bqkhd->bqhd', p, vs).astype(qblk.dtype)

    return _query_block_sweep(step, Q_BLOCK, q, q_idx, w_idx)


def setup_inputs(seed: int = 0) -> dict:
    key = jax.random.key(seed)
    ks = jax.random.split(key, 24)

    def nrm(k, shape, scale):
        return jax.random.normal(k, shape, F32) * scale

    def gain(k, shape):
        return 1.0 + 0.02 * jax.random.normal(k, shape, F32)

    L = DEPTH
    x = nrm(ks[0], (BATCH, SEQ, D_MODEL), 1.0)
    mem = nrm(ks[1], (BATCH, MEM_LEN, D_MODEL), 1.0)
    positions = (jax.random.randint(ks[2], (BATCH, 1), 0, 1024, dtype=jnp.int32)
                 + jnp.arange(SEQ, dtype=jnp.int32)[None, :])
    return {
        'x': x,
        'mem': mem,
        'positions': positions,
        'attn_norm': gain(ks[3], (L, D_MODEL)),
        'w_in': nrm(ks[4], (L, D_MODEL, D_IN), D_MODEL ** -0.5),
        'moba_qk_gain': gain(ks[5], (L, 2, HEAD_DIM)),
        'diff_qk_gain': gain(ks[6], (L, 2, DIFF_QK_DIM)),
        'diff_lambda': nrm(ks[7], (L, 4, DIFF_QK_DIM), 0.1),
        'diff_subln': gain(ks[8], (L, DIFF_V_DIM)),
        'dsa_qk_gain': gain(ks[9], (L, 2, HEAD_DIM)),
        'w_out': nrm(ks[10], (L, D_MIX, D_MODEL), D_MIX ** -0.5),
        'cross_norm': gain(ks[11], (L, D_MODEL)),
        'mem_norm': gain(ks[12], (L, D_MODEL)),
        'cross_wq': nrm(ks[13], (L, D_MODEL, CROSS_W), D_MODEL ** -0.5),
        'cross_wkv': nrm(ks[14], (L, D_MODEL, 2 * CROSS_W), D_MODEL ** -0.5),
        'cross_qk_gain': gain(ks[15], (L, 2, HEAD_DIM)),
        'cross_wo': nrm(ks[16], (L, CROSS_W, D_MODEL), CROSS_W ** -0.5),
        'ffn_norm': gain(ks[17], (L, D_MODEL)),
        'ffn_w_up': nrm(ks[18], (L, D_MODEL, 2 * D_FF), D_MODEL ** -0.5),
        'ffn_conv_w': nrm(ks[19], (L, CONV_WIDTH, 2 * D_FF), CONV_WIDTH ** -0.5),
        'ffn_conv_b': nrm(ks[20], (L, 2 * D_FF), 0.02),
        'ffn_w_down': nrm(ks[21], (L, D_FF, D_MODEL), D_FF ** -0.5),
    }


def reference(x, mem, positions, attn_norm, w_in, moba_qk_gain, diff_qk_gain, diff_lambda,
              diff_subln, dsa_qk_gain, w_out, cross_norm, mem_norm, cross_wq, cross_wkv,
              cross_qk_gain, cross_wo, ffn_norm, ffn_w_up, ffn_conv_w, ffn_conv_b, ffn_w_down):
    b, s, _ = x.shape
    for l in range(DEPTH):
        h = rms_norm(x, attn_norm[l])
        (mq, mk, mv, dq, dk, dv, sq, sk, sv, iq, ik, iw) = _split_columns(h @ w_in[l])

        mq = rope(rms_norm(mq.reshape(b, s, MOBA_HEADS, HEAD_DIM), moba_qk_gain[l, 0]), positions)
        mk = rope(rms_norm(mk.reshape(b, s, MOBA_HEADS, HEAD_DIM), moba_qk_gain[l, 1]), positions)
        mv = mv.reshape(b, s, MOBA_HEADS, HEAD_DIM)
        o_moba = moba_attention(mq, mk, mv).reshape(b, s, MOBA_W)

        dq = rope(rms_norm(dq.reshape(b, s, 2 * DIFF_HEADS, DIFF_QK_DIM), diff_qk_gain[l, 0]),
                  positions).reshape(b, s, DIFF_HEADS, 2, DIFF_QK_DIM)
        dk = rope(rms_norm(dk.reshape(b, s, 2 * DIFF_HEADS, DIFF_QK_DIM), diff_qk_gain[l, 1]),
                  positions).reshape(b, s, DIFF_HEADS, 2, DIFF_QK_DIM)
        dv = dv.reshape(b, s, DIFF_HEADS, DIFF_V_DIM)
        lam_init = 0.8 - 0.6 * math.exp(-0.3 * l)
        lf = diff_lambda[l].astype(F32)
        lam = jnp.exp(jnp.sum(lf[0] * lf[1])) - jnp.exp(jnp.sum(lf[2] * lf[3])) + lam_init
        o_diff = diff_attention(dq, dk, dv, lam)
        o_diff = (rms_norm(o_diff, diff_subln[l]) * (1.0 - lam_init)).reshape(b, s, DIFF_V_W)

        sq = rope(rms_norm(sq.reshape(b, s, DSA_HEADS, HEAD_DIM), dsa_qk_gain[l, 0]), positions)
        sk = rope(rms_norm(sk.reshape(b, s, DSA_HEADS, HEAD_DIM), dsa_qk_gain[l, 1]), positions)
        sv = sv.reshape(b, s, DSA_HEADS, HEAD_DIM)
        iq = rope(iq.reshape(b, s, IDX_HEADS, IDX_DIM), positions)
        ik = rope(ik.reshape(b, s, 1, IDX_DIM), positions)[:, :, 0]
        iw = iw * (IDX_HEADS ** -0.5)
        o_dsa = dsa_attention(sq, sk, sv, iq, ik, iw).reshape(b, s, DSA_W)

        mixed = jnp.concatenate([o_moba, o_diff, o_dsa], axis=-1).astype(x.dtype)
        x = x + mixed @ w_out[l]

        h = rms_norm(x, cross_norm[l])
        m = rms_norm(mem, mem_norm[l])
        n_mem = mem.shape[1]
        cq = rms_norm((h @ cross_wq[l]).reshape(b, s, CROSS_HEADS, HEAD_DIM), cross_qk_gain[l, 0])
        ck, cv = jnp.split(m @ cross_wkv[l], 2, axis=-1)
        ck = rms_norm(ck.reshape(b, n_mem, CROSS_HEADS, HEAD_DIM), cross_qk_gain[l, 1])
        cv = cv.reshape(b, n_mem, CROSS_HEADS, HEAD_DIM)
        sc = jnp.einsum('bqhd,bmhd->bhqm', cq.astype(F32), ck.astype(F32)) * (HEAD_DIM ** -0.5)
        p = jax.nn.softmax(sc, axis=-1)
        co = jnp.einsum('bhqm,bmhd->bqhd', p, cv.astype(F32)).reshape(b, s, CROSS_W)
        x = x + co.astype(x.dtype) @ cross_wo[l]

        h = rms_norm(x, ffn_norm[l])
        u = h @ ffn_w_up[l]
        up = jnp.pad(u, ((0, 0), (CONV_WIDTH - 1, 0), (0, 0)))
        cw = ffn_conv_w[l]
        uc = (cw[0] * up[:, :-2] + cw[1] * up[:, 1:-1] + cw[2] * up[:, 2:] + ffn_conv_b[l])
        g, val = jnp.split(uc, 2, axis=-1)
        x = x + (jax.nn.silu(g) * val) @ ffn_w_down[l]
    return x
```

```cpp
#include <hip/hip_runtime.h>
#include <hip/hip_cooperative_groups.h>
#include <stdint.h>
#include <math.h>
#include <stdio.h>
#include <string.h>
namespace cg = cooperative_groups;

#ifndef MULTI
#define MULTI 0
#endif

typedef unsigned short u16;
typedef unsigned int u32;
typedef unsigned long long u64;
using bf16x8 = __attribute__((ext_vector_type(8))) short;
using s16x4 = __attribute__((ext_vector_type(4))) short;
using f32x16 = __attribute__((ext_vector_type(16))) float;
using f32x4 = __attribute__((ext_vector_type(4))) float;
using u32x4 = __attribute__((ext_vector_type(4))) unsigned;
using u32x2 = __attribute__((ext_vector_type(2))) unsigned;
typedef __bf16 bf2_t __attribute__((ext_vector_type(2)));
typedef float f2_t __attribute__((ext_vector_type(2)));
#define DI __device__ __forceinline__
#define NEG_INF (-__builtin_inff())

constexpr int S_ = 8192, D_ = 2048, DIN = 6728, DINP = 6784, DFF = 5504, DFF2 = 11008, MEML = 256;
constexpr int C_MQ = 0, C_MK = 768, C_MV = 1536, C_DQ = 2304, C_DK = 2816, C_DV = 3328, C_SQ = 3840, C_SK = 4608, C_SV = 5376,
              C_IQ = 6144, C_IK = 6656, C_IW = 6720;
constexpr int NTHR = 256;
constexpr int SEL_BLOCKS = 256;

struct Params {
  const float *x, *mem; const int* pos;
  const float *attn_norm, *w_in, *moba_g, *diff_g, *diff_lam, *diff_subln, *dsa_g, *w_out, *cross_norm, *mem_norm, *cross_wq,
      *cross_wkv, *cross_g, *cross_wo, *ffn_norm, *w_up, *conv_w, *conv_b, *w_down;
  float* out;
  u16 *wt_in, *wt_out, *wt_cq, *wt_ckv, *wt_co, *wt_up, *wt_down;
  u16 *hbuf, *proj, *vT, *mixed, *cq, *co, *ck, *cvT, *mnorm, *ubuf, *act;
  u32 *dmask, *scores; float *kbar, *iw, *dscr; int* counters; unsigned* bar;
  float inv128[64]; float inv64[32];
};

DI u32 pack2(float a, float b) { f2_t v = {a, b}; return __builtin_bit_cast(u32, __builtin_convertvector(v, bf2_t)); }
DI float bflo(u32 w) { return __uint_as_float(w << 16); }
DI float bfhi(u32 w) { return __uint_as_float(w & 0xffff0000u); }
DI int crow(int i, int h) { return (i & 3) + 8 * (i >> 2) + 4 * h; }
DI f32x16 mfma32(bf16x8 a, bf16x8 b, f32x16 c) { return __builtin_amdgcn_mfma_f32_32x32x16_bf16(a, b, c, 0, 0, 0); }
DI f32x4 mfma16(bf16x8 a, bf16x8 b, f32x4 c) { return __builtin_amdgcn_mfma_f32_16x16x32_bf16(a, b, c, 0, 0, 0); }
DI int ltid() { int t = __builtin_amdgcn_workitem_id_x(); asm volatile("" : "+v"(t)); return t; }
DI int lbid() { int b = __builtin_amdgcn_workgroup_id_x(); asm volatile("" : "+s"(b)); return b; }
DI void dma16(const void* g, void* l) { __builtin_amdgcn_global_load_lds((const unsigned*)g, (unsigned*)l, 16, 0, 0); }
DI float wave_sum(float v) {
#pragma unroll
  for (int o = 32; o >= 1; o >>= 1) v += __shfl_xor(v, o);
  return v;
}

DI int next_item(int* counter, unsigned char* smem) {
  __syncthreads();
  if (ltid() == 0) { ((int*)smem)[0] = atomicAdd(counter, 1); ((u32*)smem)[1] = 0u; }
  __syncthreads();
  const int it = ((volatile int*)smem)[0];
  __syncthreads();
  return it;
}

DI void convert_tile(const float* __restrict__ W, int K, int N, u16* __restrict__ Wt, int kt, int nt, float* tl) {
  const int tid = ltid(), ty = tid >> 5, tx = tid & 31;
  const int k0 = kt * 64, n0 = nt * 128;
  float4 v[8];
#pragma unroll
  for (int i = 0; i < 8; ++i) {
    const int k = k0 + ty + 8 * i, n = n0 + 4 * tx;
    v[i] = make_float4(0.f, 0.f, 0.f, 0.f);
    if (n < N) v[i] = *(const float4*)(W + (size_t)k * N + n);
  }
#pragma unroll
  for (int i = 0; i < 8; ++i) {
    float* d = tl + (ty + 8 * i) * 129 + 4 * tx;
    d[0] = v[i].x; d[1] = v[i].y; d[2] = v[i].z; d[3] = v[i].w;
  }
  __syncthreads();
  {
    const int n = tid >> 1, kc = tid & 1;
    u32 w[16];
#pragma unroll
    for (int j = 0; j < 16; ++j) w[j] = pack2(tl[(kc * 32 + 2 * j) * 129 + n], tl[(kc * 32 + 2 * j + 1) * 129 + n]);
    uint4* dst = (uint4*)(Wt + (size_t)(n0 + n) * K + k0 + kc * 32);
#pragma unroll
    for (int j = 0; j < 4; ++j) dst[j] = make_uint4(w[4 * j], w[4 * j + 1], w[4 * j + 2], w[4 * j + 3]);
  }
  __syncthreads();
}

DI void rownorm(const float* __restrict__ x, const float* __restrict__ g, u16* __restrict__ out, int row) {
  const int lane = ltid() & 63;
  const float4* xr = (const float4*)(x + (size_t)row * D_);
  float4 v[8];
  float ss = 0.f;
#pragma unroll
  for (int i = 0; i < 8; ++i) {
    v[i] = xr[lane + 64 * i];
    ss += v[i].x * v[i].x + v[i].y * v[i].y + v[i].z * v[i].z + v[i].w * v[i].w;
  }
  ss = wave_sum(ss);
  const float rs = rsqrtf(ss * (1.0f / D_) + 1e-6f);
  uint2* o = (uint2*)(out + (size_t)row * D_);
#pragma unroll
  for (int i = 0; i < 8; ++i) {
    float4 gg = ((const float4*)g)[lane + 64 * i];
    o[lane + 64 * i] = make_uint2(pack2(v[i].x * rs * gg.x, v[i].y * rs * gg.y), pack2(v[i].z * rs * gg.z, v[i].w * rs * gg.w));
  }
}

enum { K_NR128 = 0, K_NR64, K_R64, K_VT, K_IKIW, K_N128, K_RAW };
struct EpiStage {
  int kind; const float* gain; u16* out; int ldo; int col; u16* vt; int vtS;
};

DI void rope_cs(float posf, float inv, float& c, float& s) {
  double rev = (double)posf * (double)inv * 0.15915494309189535;
  rev = rev - floor(rev);
  float fr = (float)rev;
  s = __builtin_amdgcn_sinf(fr);
  c = __builtin_amdgcn_cosf(fr);
}

DI void epi_rows(const Params& p, const float* cs, const EpiStage& es, int mrow0) {
  const int tid = ltid();
  if (es.kind == K_VT) {
    const int c = tid >> 1, rh = tid & 1;
    u32 w[16];
#pragma unroll
    for (int j = 0; j < 16; ++j) w[j] = pack2(cs[(32 * rh + 2 * j) * 132 + c], cs[(32 * rh + 2 * j + 1) * 132 + c]);
    uint4* dst = (uint4*)(es.vt + (size_t)c * es.vtS + mrow0 + 32 * rh);
    dst[0] = make_uint4(w[0], w[1], w[4], w[5]);
    dst[1] = make_uint4(w[2], w[3], w[6], w[7]);
    dst[2] = make_uint4(w[8], w[9], w[12], w[13]);
    dst[3] = make_uint4(w[10], w[11], w[14], w[15]);
    return;
  }
  const int r = tid >> 2, qd = tid & 3;
  const int m = mrow0 + r;
  const float* cr = cs + r * 132;
  if (es.kind == K_RAW) {
    u32 w[16];
#pragma unroll
    for (int j = 0; j < 8; ++j) {
      float4 v = *(const float4*)(cr + 32 * qd + 4 * j);
      w[2 * j] = pack2(v.x, v.y); w[2 * j + 1] = pack2(v.z, v.w);
    }
    uint4* dst = (uint4*)(es.out + (size_t)m * es.ldo + es.col + 32 * qd);
#pragma unroll
    for (int j = 0; j < 4; ++j) dst[j] = make_uint4(w[4 * j], w[4 * j + 1], w[4 * j + 2], w[4 * j + 3]);
    return;
  }
  const bool d64 = !(es.kind == K_NR128 || es.kind == K_N128);
  const int hd = d64 ? (qd >> 1) : 0, sub = d64 ? (qd & 1) : qd, half = d64 ? 32 : 64;
  const int cl = hd * 64 + sub * 16, ch = cl + half;
  float lo[16], hi[16];
#pragma unroll
  for (int j = 0; j < 4; ++j) {
    float4 a = *(const float4*)(cr + cl + 4 * j), b = *(const float4*)(cr + ch + 4 * j);
    lo[4 * j] = a.x; lo[4 * j + 1] = a.y; lo[4 * j + 2] = a.z; lo[4 * j + 3] = a.w;
    hi[4 * j] = b.x; hi[4 * j + 1] = b.y; hi[4 * j + 2] = b.z; hi[4 * j + 3] = b.w;
  }
  float ss = 0.f;
#pragma unroll
  for (int j = 0; j < 16; ++j) ss += lo[j] * lo[j] + hi[j] * hi[j];
  ss += __shfl_xor(ss, 1);
  const float ss2 = ss + __shfl_xor(ss, 2);
  if (!d64) ss = ss2;
  const bool donorm = (es.kind == K_NR128 || es.kind == K_NR64 || es.kind == K_N128);
  if (donorm) {
    const float rs = rsqrtf(ss * (d64 ? (1.0f / 64) : (1.0f / 128)) + 1e-6f);
#pragma unroll
    for (int j = 0; j < 16; ++j) {
      lo[j] *= rs * es.gain[sub * 16 + j];
      hi[j] *= rs * es.gain[sub * 16 + j + half];
    }
  }
  if (es.kind != K_N128) {
    const float posf = (float)p.pos[m];
#pragma unroll
    for (int j = 0; j < 16; ++j) {
      const int i = sub * 16 + j;
      const float inv = d64 ? p.inv64[i] : p.inv128[i];
      float c, s;
      rope_cs(posf, inv, c, s);
      const float a = lo[j], b = hi[j];
      lo[j] = a * c - b * s;
      hi[j] = b * c + a * s;
    }
  }
  if (es.kind == K_IKIW) {
    if (qd == 2) {
      float4 a = *(const float4*)(cr + 64), b = *(const float4*)(cr + 68);
      float4* d = (float4*)(p.iw + (size_t)m * 8);
      d[0] = a; d[1] = b;
    }
    if (qd >= 2) return;
  }
  u16* orow = es.out + (size_t)m * es.ldo + es.col;
  uint4* d0 = (uint4*)(orow + cl);
  uint4* d1 = (uint4*)(orow + ch);
  d0[0] = make_uint4(pack2(lo[0], lo[1]), pack2(lo[2], lo[3]), pack2(lo[4], lo[5]), pack2(lo[6], lo[7]));
  d0[1] = make_uint4(pack2(lo[8], lo[9]), pack2(lo[10], lo[11]), pack2(lo[12], lo[13]), pack2(lo[14], lo[15]));
  d1[0] = make_uint4(pack2(hi[0], hi[1]), pack2(hi[2], hi[3]), pack2(hi[4], hi[5]), pack2(hi[6], hi[7]));
  d1[1] = make_uint4(pack2(hi[8], hi[9]), pack2(hi[10], hi[11]), pack2(hi[12], hi[13]), pack2(hi[14], hi[15]));
}

template <int EPI>
DI void gemm_tile(const Params& p, const u16* __restrict__ A, int lda, const u16* __restrict__ Bt, int ldb, int K, int m0, int n0,
                  unsigned char* smem, const EpiStage& es, const float* res, float* outp) {
  const int tid = ltid(), lane = tid & 63, wid = tid >> 6, wm = wid >> 1, wn = wid & 1;
  const int lr = lane & 31, lh = lane >> 5;
  f32x16 acc[2][2];
#pragma unroll
  for (int a = 0; a < 2; ++a)
#pragma unroll
    for (int b = 0; b < 2; ++b)
#pragma unroll
      for (int i = 0; i < 16; ++i) acc[a][b][i] = 0.f;

  const u16* Ag = A + (size_t)(m0 + (tid >> 3)) * lda + (((tid & 7) ^ ((tid >> 4) & 7)) << 3);
  const u16* Bg = Bt + (size_t)(n0 + (tid >> 3)) * ldb + (((tid & 7) ^ ((tid >> 4) & 7)) << 3);
  const int wofs = tid * 16;
  const int sw = (lr >> 1) & 7;
  const int aofs = (wm * 64 + lr) * 128, bofs = 16384 + (wn * 64 + lr) * 128;
  const int nk = K >> 6;
#define G_DMA(BUF, KT) _Pragma("unroll") for (int i = 0; i < 4; ++i) { \
    dma16(Ag + (size_t)(32 * i) * lda + (KT) * 64, smem + (BUF) * 32768 + wofs + i * 4096); \
    dma16(Bg + (size_t)(32 * i) * ldb + (KT) * 64, smem + (BUF) * 32768 + 16384 + wofs + i * 4096); }
#define G_LANDED() asm volatile("s_waitcnt vmcnt(0)" ::: "memory")
#define G_COMPUTE(BUF, DMA_STMT) { const unsigned char* sb = smem + (BUF) * 32768; \
    bf16x8 fa0[4], fa1[4], fb0[4], fb1[4]; \
    _Pragma("unroll") for (int ks = 0; ks < 4; ++ks) { \
      const int co = ((2 * ks + lh) ^ sw) << 4; \
      fa0[ks] = *(const bf16x8*)(sb + aofs + co); \
      fb0[ks] = *(const bf16x8*)(sb + bofs + co); \
      fa1[ks] = *(const bf16x8*)(sb + aofs + 4096 + co); \
      fb1[ks] = *(const bf16x8*)(sb + bofs + 4096 + co); } \
    __builtin_amdgcn_sched_barrier(0); \
    DMA_STMT; \
    __builtin_amdgcn_sched_barrier(0); \
    _Pragma("unroll") for (int ks = 0; ks < 4; ++ks) { \
      acc[0][0] = mfma32(fa0[ks], fb0[ks], acc[0][0]); \
      acc[0][1] = mfma32(fa0[ks], fb1[ks], acc[0][1]); \
      acc[1][0] = mfma32(fa1[ks], fb0[ks], acc[1][0]); \
      acc[1][1] = mfma32(fa1[ks], fb1[ks], acc[1][1]); } \
    __builtin_amdgcn_sched_barrier(0); }
  G_DMA(0, 0);
  G_LANDED();
  __syncthreads();
  for (int kt = 0; kt < nk; kt += 2) {
    G_COMPUTE(0, G_DMA(1, kt + 1));
    G_LANDED();
    __syncthreads();
    const int kl = (kt + 2 < nk) ? kt + 2 : nk - 1;
    G_COMPUTE(1, G_DMA(0, kl));
    G_LANDED();
    __syncthreads();
  }
#undef G_DMA
#undef G_LANDED
#undef G_COMPUTE
  if (EPI == 1) {
#pragma unroll
    for (int mb = 0; mb < 2; ++mb)
#pragma unroll
      for (int nb = 0; nb < 2; ++nb)
#pragma unroll
        for (int i = 0; i < 16; ++i) {
          const size_t idx = (size_t)(m0 + wm * 64 + mb * 32 + crow(i, lh)) * D_ + n0 + wn * 64 + nb * 32 + lr;
          outp[idx] = res[idx] + acc[mb][nb][i];
        }
  } else {
    float* cs = (float*)smem;
#pragma unroll
    for (int ps = 0; ps < 2; ++ps) {
      if (wm == ps) {
#pragma unroll
        for (int mb = 0; mb < 2; ++mb)
#pragma unroll
          for (int nb = 0; nb < 2; ++nb)
#pragma unroll
            for (int i = 0; i < 16; ++i) cs[(mb * 32 + crow(i, lh)) * 132 + wn * 64 + nb * 32 + lr] = acc[mb][nb][i];
      }
      __syncthreads();
      epi_rows(p, cs, es, m0 + 64 * ps);
      __syncthreads();
    }
  }
}

template <int DQK, int MODE, int ldq, int ldk, int ldv>
DI void attn_core(const u16* __restrict__ Q, const u16* __restrict__ Kp, const u16* __restrict__ Vt, int q0,
                  int kt_lo, int nkt, float sc2, const u32* __restrict__ dmask, const float* __restrict__ kbar_h, unsigned char* smem,
                  f32x16 (&O)[4], float& l_out, float& m_out) {
  constexpr int NKS = DQK / 16, RB = DQK * 2, CPR = RB / 16, KCH = 64 * CPR / NTHR;
  const int tid = ltid(), lane = tid & 63, wid = tid >> 6, lr = lane & 31, lh = lane >> 5;
  const int qw0 = q0 + 32 * wid, q = qw0 + lr;
  const int cur = q0 >> 8;
  bf16x8 qf[NKS];
  if (MODE != 2) {
#pragma unroll
    for (int ks = 0; ks < NKS; ++ks) qf[ks] = *(const bf16x8*)(Q + (size_t)q * ldq + ks * 16 + lh * 8);
  }
  float m = -1e30f, l = 0.f;
  u32 selw = 0, un = 0xffffffffu;
  if (MODE == 2) {
    f32x16 G;
#pragma unroll
    for (int i = 0; i < 16; ++i) G[i] = 0.f;
    bf16x8 gq[8];
#pragma unroll
    for (int ks = 0; ks < 8; ++ks) gq[ks] = *(const bf16x8*)(Q + (size_t)q * ldq + ks * 16 + lh * 8);
#pragma unroll
    for (int ks = 0; ks < 8; ++ks) {
      const float* kp = kbar_h + (size_t)lr * 768 + ks * 16 + lh * 8;
      float4 a = *(const float4*)kp, b = *(const float4*)(kp + 4);
      u32 h0 = pack2(a.x, a.y), h1 = pack2(a.z, a.w), h2 = pack2(b.x, b.y), h3 = pack2(b.z, b.w);
      u32 l0 = pack2(a.x - bflo(h0), a.y - bfhi(h0)), l1 = pack2(a.z - bflo(h1), a.w - bfhi(h1));
      u32 l2 = pack2(b.x - bflo(h2), b.y - bfhi(h2)), l3 = pack2(b.z - bflo(h3), b.w - bfhi(h3));
      u32x4 hv = {h0, h1, h2, h3}, lv = {l0, l1, l2, l3};
      G = mfma32(__builtin_bit_cast(bf16x8, hv), gq[ks], G);
      G = mfma32(__builtin_bit_cast(bf16x8, lv), gq[ks], G);
      if ((ks & 1) == 1) __builtin_amdgcn_sched_barrier(0);
    }
    float b0 = NEG_INF, b1 = NEG_INF, b2 = NEG_INF;
    int i0 = 0, i1 = 0, i2 = 0;
#pragma unroll
    for (int ig = 0; ig < 4; ++ig) {
#pragma unroll
      for (int hh = 0; hh < 2; ++hh) {
#pragma unroll
        for (int j = 0; j < 4; ++j) {
          const int i = 4 * ig + j;
          const float o = __shfl_xor(G[i], 32);
          const int n = 8 * ig + 4 * hh + j;
          float v = (hh == lh) ? G[i] : o;
          v = (n < cur) ? v : NEG_INF;
          const bool g0 = v > b0, g1 = v > b1, g2 = v > b2;
          b2 = g1 ? b1 : (g2 ? v : b2); i2 = g1 ? i1 : (g2 ? n : i2);
          b1 = g0 ? b0 : (g1 ? v : b1); i1 = g0 ? i0 : (g1 ? n : i1);
          b0 = g0 ? v : b0;             i0 = g0 ? n : i0;
        }
      }
    }
    if (b0 > NEG_INF) selw |= 1u << i0;
    if (b1 > NEG_INF) selw |= 1u << i1;
    if (b2 > NEG_INF) selw |= 1u << i2;
    atomicOr(((u32*)smem) + 1, selw);
    __syncthreads();
    un = ((volatile u32*)smem)[1];
    __syncthreads();
    {
      const u16* Q2 = Q + (size_t)q * ldq + lh * 8;
      asm volatile("" : "+v"(Q2));
#pragma unroll
      for (int ks = 0; ks < NKS; ++ks) qf[ks] = *(const bf16x8*)(Q2 + ks * 16);
    }
  }

#pragma unroll
  for (int b = 0; b < 4; ++b)
#pragma unroll
    for (int i = 0; i < 16; ++i) O[b][i] = 0.f;
  const int swzK = (DQK == 128) ? (lr & 15) : ((lr >> 1) & 7);
  const int vsw = (lr >> 1) & 7;
  constexpr int RPI = NTHR / CPR;
  const int kr0 = tid / CPR, kch = tid % CPR;
  const int kszw = (DQK == 128) ? (kr0 & 15) : ((kr0 >> 1) & 7);
  const int kwofs = kr0 * RB + (kch << 4);
  const int klane = kr0 * ldk + ((kch ^ kszw) << 3);
  const int vr0 = tid >> 3, vch = tid & 7, vszw = (vr0 >> 1) & 7;
  const int vwofs = 16384 + vr0 * 128 + (vch << 4);
  const int vlane = vr0 * ldv + ((vch ^ vszw) << 3);
  u32x2 mw = {0u, 0u}, mwn = {0u, 0u};

  int kt = kt_lo;
  if (MODE == 2) { while (kt < nkt && !((kt >> 2) == cur || ((un >> (kt >> 2)) & 1))) ++kt; }
  {
    const int kp = (kt < nkt) ? kt : nkt - 1;
#pragma unroll
    for (int i = 0; i < KCH; ++i) dma16(Kp + (size_t)(kp * 64 + i * RPI) * ldk + klane, smem + kwofs + i * (RPI * RB));
#pragma unroll
    for (int i = 0; i < 4; ++i) dma16(Vt + (size_t)(i * 32) * ldv + kp * 64 + vlane, smem + vwofs + i * 4096);
    if (MODE == 3 && q0 >= 256) mw = *(const u32x2*)(dmask + (size_t)q * 256 + (kp * 2));
  }
  asm volatile("s_waitcnt vmcnt(0)" ::: "memory");
  __syncthreads();
  int buf = 0;
#pragma clang loop unroll(disable)
  while (kt < nkt) {
    int nx = kt + 1;
    if (MODE == 2) { while (nx < nkt && !((nx >> 2) == cur || ((un >> (nx >> 2)) & 1))) ++nx; }
    const bool more = nx < nkt;
    unsigned char* sn = smem + (buf ^ 1) * 32768;
    const int k0 = kt * 64;
    const bool active = (MODE == 0) || (k0 <= qw0 + 31);
    const unsigned char* kb = smem + buf * 32768;
    const unsigned char* vb = kb + 16384;
#pragma unroll
    for (int sub = 0; sub < 2; ++sub) {
      if (active) {
        f32x16 Sx;
#pragma unroll
        for (int i = 0; i < 16; ++i) Sx[i] = 0.f;
#pragma unroll
        for (int kh = 0; kh < NKS; kh += 4) {
          bf16x8 kf[4];
#pragma unroll
          for (int ks = 0; ks < 4; ++ks) kf[ks] = *(const bf16x8*)(kb + (32 * sub + lr) * RB + (((2 * (kh + ks) + lh) ^ swzK) << 4));
          __builtin_amdgcn_sched_barrier(0);
#pragma unroll
          for (int ks = 0; ks < 4; ++ks) Sx = mfma32(kf[ks], qf[kh + ks], Sx);
        }
        bf16x8 vf0[4], vf1[4];
        {
          const int c16 = 4 * sub + lh;
#pragma unroll
          for (int b = 0; b < 4; ++b) vf0[b] = *(const bf16x8*)(vb + (32 * b + lr) * 128 + ((c16 ^ vsw) << 4));
        }
        __builtin_amdgcn_sched_barrier(0);
        float mx = fmaxf(fmaxf(Sx[0], Sx[1]), fmaxf(Sx[2], Sx[3]));
#pragma unroll
        for (int i = 4; i < 16; i += 2) mx = fmaxf(mx, fmaxf(Sx[i], Sx[i + 1]));
        mx = fmaxf(mx, __shfl_xor(mx, 32));
        const float mnew = fmaxf(m, mx);
        const float alpha = __builtin_amdgcn_exp2f((m - mnew) * sc2);
        m = mnew;
        float negm = -mnew * sc2;
        if (MODE == 2) { const int b = k0 >> 8; if (b != cur && !((selw >> b) & 1)) negm = NEG_INF; }
#pragma unroll
        for (int i = 0; i < 16; ++i) Sx[i] = __builtin_amdgcn_exp2f(__builtin_fmaf(Sx[i], sc2, negm));
        if (MODE == 3 && q0 >= 256) {
          const u32 wsh = (sub ? mw.y : mw.x) >> (4 * lh);
#pragma unroll
          for (int i = 0; i < 16; ++i) {
            const int t = __builtin_amdgcn_sbfe((int)wsh, (i & 3) + 8 * (i >> 2), 1);
            Sx[i] = __uint_as_float(__float_as_uint(Sx[i]) & (u32)t);
          }
        } else if (MODE != 0) {
          if (k0 + 32 * sub + 31 > qw0) {
            const int thr = q - k0 - 32 * sub - 4 * lh;
#pragma unroll
            for (int i = 0; i < 16; ++i) Sx[i] = (((i & 3) + 8 * (i >> 2)) > thr) ? 0.f : Sx[i];
          }
        }
        float ls = 0.f;
#pragma unroll
        for (int i = 0; i < 16; ++i) ls += Sx[i];
        l = l * alpha + ls;
        if (__ballot(alpha != 1.0f) != 0ull) {
#pragma unroll
          for (int b = 0; b < 4; ++b)
#pragma unroll
            for (int i = 0; i < 16; ++i) O[b][i] *= alpha;
        }
        {
          const int c16 = 4 * sub + 2 + lh;
#pragma unroll
          for (int b = 0; b < 4; ++b) vf1[b] = *(const bf16x8*)(vb + (32 * b + lr) * 128 + ((c16 ^ vsw) << 4));
        }
        __builtin_amdgcn_sched_barrier(0);
        {
          u32x4 pw = {pack2(Sx[0], Sx[1]), pack2(Sx[2], Sx[3]), pack2(Sx[4], Sx[5]), pack2(Sx[6], Sx[7])};
          const bf16x8 pf = __builtin_bit_cast(bf16x8, pw);
#pragma unroll
          for (int b = 0; b < 4; ++b) O[b] = mfma32(vf0[b], pf, O[b]);
        }
        {
          u32x4 pw = {pack2(Sx[8], Sx[9]), pack2(Sx[10], Sx[11]), pack2(Sx[12], Sx[13]), pack2(Sx[14], Sx[15])};
          const bf16x8 pf = __builtin_bit_cast(bf16x8, pw);
#pragma unroll
          for (int b = 0; b < 4; ++b) O[b] = mfma32(vf1[b], pf, O[b]);
        }
      }
      if (sub == 0 && more) {
#pragma unroll
        for (int i = 0; i < KCH; ++i) dma16(Kp + (size_t)(nx * 64 + i * RPI) * ldk + klane, sn + kwofs + i * (RPI * RB));
#pragma unroll
        for (int i = 0; i < 4; ++i) dma16(Vt + (size_t)(i * 32) * ldv + nx * 64 + vlane, sn + vwofs + i * 4096);
        if (MODE == 3 && q0 >= 256) mwn = *(const u32x2*)(dmask + (size_t)q * 256 + (nx * 2));
      }
    }
    asm volatile("s_waitcnt vmcnt(0)" ::: "memory");
    __syncthreads();
    mw = mwn;
    kt = nx;
    buf ^= 1;
  }
  l_out = l + __shfl_xor(l, 32);
  m_out = m;
}

DI void write_O_bf16(const f32x16 (&O)[4], float linv, u16* __restrict__ out, int ldo, int q) {
  const int lh = (ltid() & 63) >> 5;
#pragma unroll
  for (int b = 0; b < 4; ++b)
#pragma unroll
    for (int g = 0; g < 4; ++g) {
      uint2 w = make_uint2(pack2(O[b][4 * g] * linv, O[b][4 * g + 1] * linv), pack2(O[b][4 * g + 2] * linv, O[b][4 * g + 3] * linv));
      *(uint2*)(out + (size_t)q * ldo + 32 * b + 8 * g + 4 * lh) = w;
    }
}

DI u32 f2key(float f) {
  u32 u = __float_as_uint(f + 0.0f);
  return (u & 0x80000000u) ? ~u : (u | 0x80000000u);
}
DI u32 ld_scr(const u32* p) { return __hip_atomic_load((u32*)p, __ATOMIC_RELAXED, __HIP_MEMORY_SCOPE_AGENT); }

DI void radix_extract(const u32* hrow, int lane, int& kneed, u32& digit_out) {
  int cnt[32];
#pragma unroll
  for (int j = 0; j < 4; ++j) {
    const uint4 v = ((const uint4*)hrow)[lane * 4 + j];
    cnt[8 * j + 0] = (int)(v.x & 0xffffu); cnt[8 * j + 1] = (int)(v.x >> 16);
    cnt[8 * j + 2] = (int)(v.y & 0xffffu); cnt[8 * j + 3] = (int)(v.y >> 16);
    cnt[8 * j + 4] = (int)(v.z & 0xffffu); cnt[8 * j + 5] = (int)(v.z >> 16);
    cnt[8 * j + 6] = (int)(v.w & 0xffffu); cnt[8 * j + 7] = (int)(v.w >> 16);
  }
  int local = 0;
#pragma unroll
  for (int j = 0; j < 32; ++j) local += cnt[j];
  int incl = local;
#pragma unroll
  for (int o = 1; o < 64; o <<= 1) {
    const int v = __shfl_down(incl, o);
    if (lane + o < 64) incl += v;
  }
  const int above = incl - local;
  const bool found = (above < kneed) && (kneed <= incl);
  int digit = 0, newk = 0;
  {
    int cum = above;
    bool done = false;
#pragma unroll
    for (int b = 31; b >= 0; --b) {
      if (!done && cum + cnt[b] >= kneed) { digit = 32 * lane + b; newk = kneed - cum; done = true; }
      cum += cnt[b];
    }
  }
  const u64 fm = __ballot(found);
  const int src = (int)__builtin_ctzll(fm);
  digit_out = (u32)__shfl(digit, src);
  kneed = __shfl(newk, src);
}

DI void dsa_select_item(const Params& p, int rb, unsigned char* smem) {
  const int tid = ltid(), lane = tid & 63, wid = tid >> 6, fr = lane & 15, fq = lane >> 4;
  const int t0 = rb * 16;
  u32* scr = p.scores + (size_t)blockIdx.x * (16 * 8192);
  u32* hist0 = (u32*)smem;
#pragma unroll
  for (int j = 0; j < 16; ++j) ((uint4*)hist0)[tid + 256 * j] = make_uint4(0, 0, 0, 0);
  __syncthreads();
  {
    const u16* iq = p.proj + C_IQ;
    const u16* ik = p.proj + C_IK;
    bf16x8 qa[8][2];
#pragma unroll
    for (int hd = 0; hd < 8; ++hd)
#pragma unroll
      for (int ks = 0; ks < 2; ++ks) qa[hd][ks] = *(const bf16x8*)(iq + (size_t)(t0 + fr) * DIN + hd * 64 + ks * 32 + fq * 8);
    float w[4][8];
#pragma unroll
    for (int j = 0; j < 4; ++j) {
      const float4* wp = (const float4*)(p.iw + (size_t)(t0 + 4 * fq + j) * 8);
      float4 a = wp[0], b = wp[1];
      w[j][0] = a.x; w[j][1] = a.y; w[j][2] = a.z; w[j][3] = a.w; w[j][4] = b.x; w[j][5] = b.y; w[j][6] = b.z; w[j][7] = b.w;
    }
    const int ntile = rb + 1, last = ntile - 1;
    bf16x8 c0, c1, a0, a1, b0, b1;
    {
      const int k0 = (wid < ntile ? wid : last) * 16, k1 = (wid + 4 < ntile ? wid + 4 : last) * 16, k2 = (wid + 8 < ntile ? wid + 8 : last) * 16;
      c0 = *(const bf16x8*)(ik + (size_t)(k0 + fr) * DIN + fq * 8); c1 = *(const bf16x8*)(ik + (size_t)(k0 + fr) * DIN + 32 + fq * 8);
      a0 = *(const bf16x8*)(ik + (size_t)(k1 + fr) * DIN + fq * 8); a1 = *(const bf16x8*)(ik + (size_t)(k1 + fr) * DIN + 32 + fq * 8);
      b0 = *(const bf16x8*)(ik + (size_t)(k2 + fr) * DIN + fq * 8); b1 = *(const bf16x8*)(ik + (size_t)(k2 + fr) * DIN + 32 + fq * 8);
    }
    for (int kt = wid; kt < ntile; kt += 4) {
      const int k0 = kt * 16;
      const bf16x8 kb0 = c0, kb1 = c1;
      c0 = a0; c1 = a1; a0 = b0; a1 = b1;
      {
        const int kn = (kt + 12 < ntile ? kt + 12 : last) * 16;
        b0 = *(const bf16x8*)(ik + (size_t)(kn + fr) * DIN + fq * 8);
        b1 = *(const bf16x8*)(ik + (size_t)(kn + fr) * DIN + 32 + fq * 8);
      }
      float sc[4] = {0.f, 0.f, 0.f, 0.f};
#pragma unroll
      for (int hd = 0; hd < 8; ++hd) {
        f32x4 c = {0.f, 0.f, 0.f, 0.f};
        c = mfma16(qa[hd][0], kb0, c);
        c = mfma16(qa[hd][1], kb1, c);
#pragma unroll
        for (int j = 0; j < 4; ++j) sc[j] += w[j][hd] * fmaxf(c[j], 0.f);
      }
#pragma unroll
      for (int j = 0; j < 4; ++j) {
        const int row = 4 * fq + j, key = k0 + fr;
        const bool adm = key <= t0 + row;
        const u32 kk = adm ? f2key(sc[j]) : 0u;
        scr[row * 8192 + key] = kk;
        if (adm) atomicAdd(&hist0[row * 1024 + (kk >> 22)], 1u << ((kk >> 17) & 16u));
      }
    }
  }
  asm volatile("s_waitcnt vmcnt(0)" ::: "memory");
  __syncthreads();
  __builtin_amdgcn_fence(__ATOMIC_ACQUIRE, "agent");
  u32* hist = (u32*)smem + wid * 4096;
  const int rowb = 4 * wid;
  const u32* sr0 = scr + rowb * 8192;
  const int nbase = t0 + rowb + 1;
  const int nmax = nbase + 3;
  u32 prefix[4] = {0u, 0u, 0u, 0u};
  int kneed[4] = {256, 256, 256, 256};
#pragma unroll
  for (int rr = 0; rr < 4; ++rr) { u32 d; radix_extract(hist0 + (rowb + rr) * 1024, lane, kneed[rr], d); prefix[rr] = d; }
  __syncthreads();
#pragma unroll 1
  for (int pass = 1; pass < 3; ++pass) {
    const int sh = (pass == 1) ? 10 : 0, msh = (pass == 1) ? 21 : 10;
    const u32 dmsk = (pass == 1) ? 2047u : 1023u;
#pragma unroll
    for (int j = 0; j < 16; ++j) ((uint4*)hist)[lane + 64 * j] = make_uint4(0, 0, 0, 0);
    __threadfence_block();
    for (int c0 = lane; c0 < nmax; c0 += 512) {
      u32 kk[4][8];
#pragma unroll
      for (int rr = 0; rr < 4; ++rr)
#pragma unroll
        for (int j = 0; j < 8; ++j) { const int c = c0 + 64 * j; kk[rr][j] = (c < nbase + rr) ? sr0[rr * 8192 + c] : 0u; }
#pragma unroll
      for (int rr = 0; rr < 4; ++rr)
#pragma unroll
        for (int j = 0; j < 8; ++j) {
          const int c = c0 + 64 * j;
          const u32 k = kk[rr][j];
          const bool mt = (c < nbase + rr) && ((k >> msh) == prefix[rr]);
          const u32 bin = (k >> sh) & dmsk;
          if (mt) atomicAdd(&hist[rr * 1024 + (bin >> 1)], 1u << ((bin & 1u) << 4));
        }
    }
    __threadfence_block();
#pragma unroll
    for (int rr = 0; rr < 4; ++rr) {
      u32 d;
      radix_extract(hist + rr * 1024, lane, kneed[rr], d);
      prefix[rr] = (prefix[rr] << ((pass == 1) ? 11 : 10)) | d;
    }
    __threadfence_block();
  }
  {
    int taken[4] = {0, 0, 0, 0};
    const int kend = ((t0 + rowb) | 127) + 1;
    for (int cb = 0; cb < kend; cb += 256) {
      u32 kk[4][4];
#pragma unroll
      for (int rr = 0; rr < 4; ++rr)
#pragma unroll
        for (int j = 0; j < 4; ++j) { const int c = cb + 64 * j + lane; kk[rr][j] = (c < nbase + rr) ? sr0[rr * 8192 + c] : 0u; }
#pragma unroll
      for (int rr = 0; rr < 4; ++rr) {
        const u32 T = prefix[rr];
#pragma unroll
        for (int j = 0; j < 4; ++j) {
          const int c0 = cb + 64 * j, c = c0 + lane;
          const u32 k = kk[rr][j];
          const bool gt = k > T, eq = (c < nbase + rr) && (k == T);
          const u64 eqm = __ballot(eq);
          const int rank = taken[rr] + __builtin_popcountll(eqm & ((1ull << lane) - 1ull));
          const bool sel = gt || (eq && rank < kneed[rr]);
          taken[rr] += __builtin_popcountll(eqm);
          const u64 sm = __ballot(sel);
          if (lane == 0 && c0 < kend) *(u64*)(p.dmask + (size_t)(t0 + rowb + rr) * 256 + (c0 >> 5)) = sm;
        }
      }
    }
  }
}

enum { PH_PREP = 0, PH_WIN, PH_MIX1, PH_MIX2, PH_WOUT, PH_NORM2, PH_CQ, PH_CROSS, PH_CO, PH_NORM3, PH_UP, PH_CONV, PH_DOWN, PH_COUNT };

DI void convert_matrix(const float* W, int K, int N, int Npad, u16* Wt, unsigned char* smem) {
  const int nkt = K / 64, cnt = nkt * (Npad / 128);
  for (int t = blockIdx.x; t < cnt; t += gridDim.x) convert_tile(W, K, N, Wt, t % nkt, t / nkt, (float*)smem);
}

DI void phase_prep(const Params& p, int layer, unsigned char* smem) {
  constexpr int T0 = (D_ / 64) * (DINP / 128), T1 = T0 + (D_ / 64) * (D_ / 128), T2 = T1 + (D_ / 64) * (512 / 128),
                T3 = T2 + (D_ / 64) * (1024 / 128), T4 = T3 + (512 / 64) * (D_ / 128), T5 = T4 + (D_ / 64) * (DFF2 / 128),
                T6 = T5 + (DFF / 64) * (D_ / 128);
  for (int t = lbid(); t < T6; t += gridDim.x) {
    const float* W; u16* Wt; int K, N, tt;
    if (t < T0) { W = p.w_in + (size_t)layer * D_ * DIN; Wt = p.wt_in; K = D_; N = DIN; tt = t; }
    else if (t < T1) { W = p.w_out + (size_t)layer * D_ * D_; Wt = p.wt_out; K = D_; N = D_; tt = t - T0; }
    else if (t < T2) { W = p.cross_wq + (size_t)layer * D_ * 512; Wt = p.wt_cq; K = D_; N = 512; tt = t - T1; }
    else if (t < T3) { W = p.cross_wkv + (size_t)layer * D_ * 1024; Wt = p.wt_ckv; K = D_; N = 1024; tt = t - T2; }
    else if (t < T4) { W = p.cross_wo + (size_t)layer * 512 * D_; Wt = p.wt_co; K = 512; N = D_; tt = t - T3; }
    else if (t < T5) { W = p.w_up + (size_t)layer * D_ * DFF2; Wt = p.wt_up; K = D_; N = DFF2; tt = t - T4; }
    else { W = p.w_down + (size_t)layer * DFF * D_; Wt = p.wt_down; K = DFF; N = D_; tt = t - T5; }
    const int nkt = K / 64;
    convert_tile(W, K, N, Wt, tt % nkt, tt / nkt, (float*)smem);
  }
  const float* xsrc = (layer == 0) ? p.x : p.out;
  const int wv = ltid() >> 6;
  for (int r = blockIdx.x * 4 + wv; r < S_ + MEML; r += gridDim.x * 4) {
    if (r < S_) rownorm(xsrc, p.attn_norm + layer * D_, p.hbuf, r);
    else rownorm(p.mem, p.mem_norm + layer * D_, p.mnorm, r - S_);
  }
}

DI void phase_norm(const Params& p, const float* g) {
  const int wv = ltid() >> 6;
  for (int r = blockIdx.x * 4 + wv; r < S_; r += gridDim.x * 4) rownorm(p.out, g, p.hbuf, r);
}

DI void phase_win(const Params& p, int layer, unsigned char* smem, int* ctr) {
  const int ntile = 64 * 53 + 16;
  for (int it = lbid(); it < ntile; it += gridDim.x) {
    __syncthreads();
    EpiStage es; es.gain = nullptr; es.out = p.proj; es.ldo = DIN; es.col = 0; es.vt = nullptr; es.vtS = S_; es.kind = K_RAW;
    if (it < 64 * 53) {
      const int mt = it & 63, nt = it >> 6, n0 = nt * 128;
      es.col = n0;
      if (n0 < C_MK) { es.kind = K_NR128; es.gain = p.moba_g + layer * 256; }
      else if (n0 < C_MV) { es.kind = K_NR128; es.gain = p.moba_g + layer * 256 + 128; }
      else if (n0 < C_DQ) { es.kind = K_VT; es.vt = p.vT + (size_t)((n0 - C_MV) >> 7) * 128 * S_; }
      else if (n0 < C_DK) { es.kind = K_NR64; es.gain = p.diff_g + layer * 128; }
      else if (n0 < C_DV) { es.kind = K_NR64; es.gain = p.diff_g + layer * 128 + 64; }
      else if (n0 < C_SQ) { es.kind = K_VT; es.vt = p.vT + (size_t)(6 + ((n0 - C_DV) >> 7)) * 128 * S_; }
      else if (n0 < C_SK) { es.kind = K_NR128; es.gain = p.dsa_g + layer * 256; }
      else if (n0 < C_SV) { es.kind = K_NR128; es.gain = p.dsa_g + layer * 256 + 128; }
      else if (n0 < C_IQ) { es.kind = K_VT; es.vt = p.vT + (size_t)(10 + ((n0 - C_SV) >> 7)) * 128 * S_; }
      else if (n0 < C_IK) { es.kind = K_R64; }
      else { es.kind = K_IKIW; }
      gemm_tile<0>(p, p.hbuf, D_, p.wt_in, D_, D_, mt * 128, n0, smem, es, nullptr, nullptr);
    } else {
      const int j = it - 64 * 53, mt = j & 1, nt = j >> 1;
      if (nt < 4) { es.kind = K_N128; es.gain = p.cross_g + layer * 256 + 128; es.out = p.ck; es.ldo = 512; es.col = nt * 128; }
      else { es.kind = K_VT; es.vt = p.cvT + (size_t)(nt - 4) * 128 * MEML; es.vtS = MEML; }
      gemm_tile<0>(p, p.mnorm, D_, p.wt_ckv, D_, D_, mt * 128, nt * 128, smem, es, nullptr, nullptr);
    }
  }
}

constexpr int PB_ROW = 272, PB_PART = 128 * PB_ROW, PB_SLOT = 2 * PB_PART;
DI void split_order(int s, int& qt, int& part, int& nparts) {
  if (s < 80) {
    const int g = s / 5, k = s % 5;
    if (k == 0) { qt = 31 - g; part = 0; nparts = 1; }
    else { qt = 63 - 2 * g - ((k - 1) >> 1); part = (k - 1) & 1; nparts = 2; }
  } else { qt = 15 - (s - 80); part = 0; nparts = 1; }
}
DI void st_wt(void* p, u32 lo, u32 hi) {
  __hip_atomic_store((u64*)p, (u64)lo | ((u64)hi << 32), __ATOMIC_RELAXED, __HIP_MEMORY_SCOPE_AGENT);
}
DI u64 ld_wt(const void* p) { return __hip_atomic_load((u64*)p, __ATOMIC_RELAXED, __HIP_MEMORY_SCOPE_AGENT); }
DI bool split_finish(f32x16 (&O)[4], float& m, float& l, float sc2, unsigned char* pslot, int part, int* flag, unsigned char* smem) {
  const int lane = ltid() & 63, wid = ltid() >> 6, lr = lane & 31, lh = lane >> 5;
  const int ql = 32 * wid + lr;
  unsigned char* mine = pslot + part * PB_PART + ql * PB_ROW;
#pragma unroll
  for (int b = 0; b < 4; ++b)
#pragma unroll
    for (int g = 0; g < 4; ++g)
      st_wt(mine + (32 * b + 8 * g + 4 * lh) * 2, pack2(O[b][4 * g], O[b][4 * g + 1]), pack2(O[b][4 * g + 2], O[b][4 * g + 3]));
  if (lh == 0) st_wt(mine + 256, __float_as_uint(m), __float_as_uint(l));
  asm volatile("s_waitcnt vmcnt(0)" ::: "memory");
  __syncthreads();
  if (ltid() == 0) ((volatile int*)smem)[2] = atomicAdd(flag, 1);
  __syncthreads();
  const int old = ((volatile int*)smem)[2];
  if (old == 0) return false;
  const unsigned char* oth = pslot + (part ^ 1) * PB_PART + ql * PB_ROW;
  const u64 mlw = ld_wt(oth + 256);
  const float m2 = __uint_as_float((u32)mlw), l2 = __uint_as_float((u32)(mlw >> 32));
  const float M = fmaxf(m, m2);
  const float a = __builtin_amdgcn_exp2f((m - M) * sc2), bb = __builtin_amdgcn_exp2f((m2 - M) * sc2);
#pragma unroll
  for (int b = 0; b < 4; ++b)
#pragma unroll
    for (int g = 0; g < 4; ++g) {
      const u64 w = ld_wt(oth + (32 * b + 8 * g + 4 * lh) * 2);
      const u32 wx = (u32)w, wy = (u32)(w >> 32);
      const u32 o0 = pack2(O[b][4 * g], O[b][4 * g + 1]), o1 = pack2(O[b][4 * g + 2], O[b][4 * g + 3]);
      O[b][4 * g] = a * bflo(o0) + bb * bflo(wx);
      O[b][4 * g + 1] = a * bfhi(o0) + bb * bfhi(wx);
      O[b][4 * g + 2] = a * bflo(o1) + bb * bflo(wy);
      O[b][4 * g + 3] = a * bfhi(o1) + bb * bfhi(wy);
    }
  l = a * l + bb * l2;
  m = M;
  return true;
}

DI void kbar_item(const Params& p, int idx, unsigned char* smem) {
  const int n = idx / 6, hd = idx % 6, tid = ltid(), d = tid & 127, hf = tid >> 7;
  const u16* kp = p.proj + (size_t)(n * 256 + hf * 128) * DIN + C_MK + hd * 128 + d;
  float s = 0.f;
  for (int j = 0; j < 128; ++j) s += __uint_as_float(((u32)kp[(size_t)j * DIN]) << 16);
  float* sm = (float*)smem + 16;
  if (hf) sm[d] = s;
  __syncthreads();
  if (!hf) p.kbar[(size_t)(n * 6 + hd) * 128 + d] = (s + sm[d]) * (1.0f / 256.0f);
}

DI void diff_item(const Params& p, int layer, int qt, int hh, int c, int part, int nparts, unsigned char* smem) {
  f32x16 O[4];
  float l, m;
  const int q0 = qt * 128, nk = 2 * qt + 2;
  const int lo = (nparts == 2 && part == 1) ? qt + 1 : 0, hi = (nparts == 2 && part == 0) ? qt + 1 : nk;
  const float sc2 = 0.125f * 1.4426950408889634f;
  attn_core<64, 1, DIN, DIN, S_>(p.proj + C_DQ + hh * 128 + c * 64, p.proj + C_DK + hh * 128 + c * 64, p.vT + (size_t)(6 + hh) * 128 * S_,
                   q0, lo, hi, sc2, nullptr, nullptr, smem, O, l, m);
  if (nparts == 2) {
    const int slot = (qt - 32) * 8 + hh * 2 + c;
    if (!split_finish(O, m, l, sc2, (unsigned char*)p.mixed + (size_t)slot * PB_SLOT, part, p.counters + 512 + layer * 1024 + slot, smem)) return;
  }
  const float linv = 1.0f / l;
  const int lane = ltid() & 63, wid = ltid() >> 6, lr = lane & 31, lh = lane >> 5;
  const int q = q0 + 32 * wid + lr;
  float* dst = p.dscr + ((size_t)(c * 4 + hh) * S_ + q) * 128;
#pragma unroll
  for (int b = 0; b < 4; ++b)
#pragma unroll
    for (int g = 0; g < 4; ++g)
      *(float4*)(dst + 32 * b + 8 * g + 4 * lh) =
          make_float4(O[b][4 * g] * linv, O[b][4 * g + 1] * linv, O[b][4 * g + 2] * linv, O[b][4 * g + 3] * linv);
}

DI void diff_combine_item(const Params& p, int layer, int qt, int hh) {
  const float* lf = p.diff_lam + layer * 256;
  float s1 = 0.f, s2 = 0.f;
  for (int j = 0; j < 64; ++j) { s1 += lf[j] * lf[64 + j]; s2 += lf[128 + j] * lf[192 + j]; }
  const float lam_init = (layer == 0) ? 0.2f : (0.8f - 0.6f * 0.74081822068171788f);
  const float lam = __expf(s1) - __expf(s2) + lam_init;
  const int tid = ltid(), r = tid >> 1, hf = tid & 1;
  const int q = qt * 128 + r;
  const float* o1 = p.dscr + ((size_t)(0 * 4 + hh) * S_ + q) * 128 + 64 * hf;
  const float* o2 = p.dscr + ((size_t)(1 * 4 + hh) * S_ + q) * 128 + 64 * hf;
  float a[64];
  float ss = 0.f;
#pragma unroll
  for (int j = 0; j < 16; ++j) {
    float4 u = ((const float4*)o1)[j], v = ((const float4*)o2)[j];
    a[4 * j] = u.x - lam * v.x; a[4 * j + 1] = u.y - lam * v.y; a[4 * j + 2] = u.z - lam * v.z; a[4 * j + 3] = u.w - lam * v.w;
    ss += a[4 * j] * a[4 * j] + a[4 * j + 1] * a[4 * j + 1] + a[4 * j + 2] * a[4 * j + 2] + a[4 * j + 3] * a[4 * j + 3];
  }
  ss += __shfl_xor(ss, 1);
  const float rs = rsqrtf(ss * (1.0f / 128) + 1e-6f) * (1.0f - lam_init);
  const float* g = p.diff_subln + layer * 128 + 64 * hf;
  uint4* dst = (uint4*)(p.mixed + (size_t)q * D_ + 768 + hh * 128 + 64 * hf);
#pragma unroll
  for (int j = 0; j < 8; ++j)
    dst[j] = make_uint4(pack2(a[8 * j] * rs * g[8 * j], a[8 * j + 1] * rs * g[8 * j + 1]),
                        pack2(a[8 * j + 2] * rs * g[8 * j + 2], a[8 * j + 3] * rs * g[8 * j + 3]),
                        pack2(a[8 * j + 4] * rs * g[8 * j + 4], a[8 * j + 5] * rs * g[8 * j + 5]),
                        pack2(a[8 * j + 6] * rs * g[8 * j + 6], a[8 * j + 7] * rs * g[8 * j + 7]));
}

DI void phase_mix1(const Params& p, int layer, unsigned char* smem, int* ctrA, int* ctrB) {
  if (blockIdx.x < SEL_BLOCKS) {
    for (;;) {
      const int it = next_item(ctrA, smem);
      if (it >= 512 - 16) break;
      dsa_select_item(p, 511 - it, smem);
    }
  }
  for (;;) {
    const int it = next_item(ctrB, smem);
    if (it >= 768 + 192) break;
    if (it < 768) {
      int qt, part, nparts;
      split_order(it >> 3, qt, part, nparts);
      diff_item(p, layer, qt, (it & 7) >> 1, it & 1, part, nparts, smem);
    } else kbar_item(p, it - 768, smem);
  }
}

DI void phase_mix2(const Params& p, int layer, unsigned char* smem, int* ctr) {
  const float sc2 = 0.08838834764831845f * 1.4426950408889634f;
  for (;;) {
    const int it = next_item(ctr, smem);
    if (it >= 1152 + 256) break;
    if (it < 1152) {
      int qt, part, nparts;
      const int wh = it % 12;
      split_order(it / 12, qt, part, nparts);
      const int q0 = qt * 128, nk = 2 * qt + 2;
      const int lo = (nparts == 2 && part == 1) ? qt + 1 : 0, hi = (nparts == 2 && part == 0) ? qt + 1 : nk;
      f32x16 O[4];
      float l, m;
      const int lane = ltid() & 63, wid = ltid() >> 6;
      const int q = q0 + 32 * wid + (lane & 31);
      if (wh < 6) {
        attn_core<128, 2, DIN, DIN, S_>(p.proj + C_MQ + wh * 128, p.proj + C_MK + wh * 128, p.vT + (size_t)wh * 128 * S_, q0,
                          lo, hi, sc2, nullptr, p.kbar + wh * 128, smem, O, l, m);
      } else {
        const int hd = wh - 6;
        attn_core<128, 3, DIN, DIN, S_>(p.proj + C_SQ + hd * 128, p.proj + C_SK + hd * 128, p.vT + (size_t)(10 + hd) * 128 * S_, q0,
                          lo, hi, sc2, p.dmask, nullptr, smem, O, l, m);
      }
      bool fin = true;
      if (nparts == 2) {
        const int slot = (qt - 32) * 12 + wh;
        fin = split_finish(O, m, l, sc2, (unsigned char*)p.scores + (size_t)slot * PB_SLOT, part, p.counters + 512 + layer * 1024 + 512 + slot, smem);
      }
      if (fin) write_O_bf16(O, 1.0f / l, p.mixed + (wh < 6 ? wh * 128 : 1280 + (wh - 6) * 128), D_, q);
    } else {
      const int j = it - 1152;
      diff_combine_item(p, layer, j >> 2, j & 3);
    }
  }
}

DI void phase_gemm_res(const Params& p, const u16* A, int lda, const u16* Bt, int K, const float* res, unsigned char* smem, int* ctr) {
  EpiStage es{};
  for (int it = lbid(); it < 64 * 16; it += gridDim.x) {
    __syncthreads();
    gemm_tile<1>(p, A, lda, Bt, K, K, (it & 63) * 128, (it >> 6) * 128, smem, es, res, p.out);
  }
}

DI void phase_cq(const Params& p, int layer, unsigned char* smem, int* ctr) {
  for (int it = lbid(); it < 64 * 4; it += gridDim.x) {
    __syncthreads();
    const int qt = it & 63, h = it >> 6, q0 = qt * 128;
    EpiStage es; es.kind = K_N128; es.gain = p.cross_g + layer * 256; es.out = p.cq; es.ldo = 512; es.col = h * 128; es.vt = nullptr; es.vtS = 0;
    gemm_tile<0>(p, p.hbuf, D_, p.wt_cq, D_, D_, q0, h * 128, smem, es, nullptr, nullptr);
    asm volatile("s_waitcnt vmcnt(0)" ::: "memory");
    __syncthreads();
    f32x16 O[4];
    float l, mdummy;
    attn_core<128, 0, 512, 512, MEML>(p.cq + h * 128, p.ck + h * 128, p.cvT + (size_t)h * 128 * MEML, q0, 0, 4,
                      0.08838834764831845f * 1.4426950408889634f, nullptr, nullptr, smem, O, l, mdummy);
    const int lane = ltid() & 63, wid = ltid() >> 6;
    write_O_bf16(O, 1.0f / l, p.co + h * 128, 512, q0 + 32 * wid + (lane & 31));
  }
}

DI void phase_cross(const Params& p, unsigned char* smem, int* ctr) {
  for (int it = lbid(); it < 256; it += gridDim.x) {
    __syncthreads();
    const int qt = it >> 2, h = it & 3, q0 = qt * 128;
    f32x16 O[4];
    float l;
    float mdummy;
    attn_core<128, 0, 512, 512, MEML>(p.cq + h * 128, p.ck + h * 128, p.cvT + (size_t)h * 128 * MEML, q0, 0, 4,
                      0.08838834764831845f * 1.4426950408889634f, nullptr, nullptr, smem, O, l, mdummy);
    const int lane = ltid() & 63, wid = ltid() >> 6;
    write_O_bf16(O, 1.0f / l, p.co + h * 128, 512, q0 + 32 * wid + (lane & 31));
  }
}

DI void phase_up(const Params& p, unsigned char* smem, int* ctr) {
  for (int it = lbid(); it < 64 * 86; it += gridDim.x) {
    __syncthreads();
    EpiStage es; es.kind = K_RAW; es.gain = nullptr; es.out = p.ubuf; es.ldo = DFF2; es.col = (it >> 6) * 128; es.vt = nullptr; es.vtS = 0;
    gemm_tile<0>(p, p.hbuf, D_, p.wt_up, D_, D_, (it & 63) * 128, (it >> 6) * 128, smem, es, nullptr, nullptr);
  }
}

DI void unpack8(uint4 a, float (&o)[8]) {
  o[0] = bflo(a.x); o[1] = bfhi(a.x); o[2] = bflo(a.y); o[3] = bfhi(a.y); o[4] = bflo(a.z); o[5] = bfhi(a.z); o[6] = bflo(a.w); o[7] = bfhi(a.w);
}

DI void phase_conv(const Params& p, int layer, unsigned char* smem, int* ctr) {
  const float* cw = p.conv_w + (size_t)layer * 3 * DFF2;
  const float* cb = p.conv_b + (size_t)layer * DFF2;
  for (int it = lbid(); it < 512; it += gridDim.x) {
    const int t0 = it * 16;
    for (int cg8 = ltid(); cg8 < DFF / 8; cg8 += NTHR) {
      const int j0 = cg8 * 8;
      float wg[3][8], wv[3][8], bg[8], bv[8];
#pragma unroll
      for (int d = 0; d < 3; ++d)
#pragma unroll
        for (int e = 0; e < 8; ++e) { wg[d][e] = cw[d * DFF2 + j0 + e]; wv[d][e] = cw[d * DFF2 + DFF + j0 + e]; }
#pragma unroll
      for (int e = 0; e < 8; ++e) { bg[e] = cb[j0 + e]; bv[e] = cb[DFF + j0 + e]; }
      float g2[8], g1[8], v2[8], v1[8];
#pragma unroll
      for (int e = 0; e < 8; ++e) { g2[e] = 0.f; g1[e] = 0.f; v2[e] = 0.f; v1[e] = 0.f; }
      if (t0 >= 2) {
        unpack8(*(const uint4*)(p.ubuf + (size_t)(t0 - 2) * DFF2 + j0), g2);
        unpack8(*(const uint4*)(p.ubuf + (size_t)(t0 - 2) * DFF2 + DFF + j0), v2);
        unpack8(*(const uint4*)(p.ubuf + (size_t)(t0 - 1) * DFF2 + j0), g1);
        unpack8(*(const uint4*)(p.ubuf + (size_t)(t0 - 1) * DFF2 + DFF + j0), v1);
      }
#pragma unroll 8
      for (int r = 0; r < 16; ++r) {
        const int t = t0 + r;
        float g0[8], v0[8], o[8];
        unpack8(*(const uint4*)(p.ubuf + (size_t)t * DFF2 + j0), g0);
        unpack8(*(const uint4*)(p.ubuf + (size_t)t * DFF2 + DFF + j0), v0);
#pragma unroll
        for (int e = 0; e < 8; ++e) {
          const float gg = wg[0][e] * g2[e] + wg[1][e] * g1[e] + wg[2][e] * g0[e] + bg[e];
          const float vv = wv[0][e] * v2[e] + wv[1][e] * v1[e] + wv[2][e] * v0[e] + bv[e];
          o[e] = gg / (1.0f + __expf(-gg)) * vv;
          g2[e] = g1[e]; g1[e] = g0[e]; v2[e] = v1[e]; v1[e] = v0[e];
        }
        *(uint4*)(p.act + (size_t)t * DFF + j0) = make_uint4(pack2(o[0], o[1]), pack2(o[2], o[3]), pack2(o[4], o[5]), pack2(o[6], o[7]));
      }
    }
  }
}

template <int PH>
DI void run_phase(const Params& p, int layer, unsigned char* smem, int cofs = 0) {
  int* ctr = p.counters + (layer * 16 + PH) + cofs;
  if (PH == PH_PREP) phase_prep(p, layer, smem);
  if (PH == PH_WIN) phase_win(p, layer, smem, ctr);
  if (PH == PH_MIX1) phase_mix1(p, layer, smem, ctr, p.counters + (layer * 16 + 14) + cofs);
  if (PH == PH_MIX2) phase_mix2(p, layer, smem, ctr);
  if (PH == PH_WOUT) phase_gemm_res(p, p.mixed, D_, p.wt_out, D_, (layer == 0) ? p.x : p.out, smem, ctr);
  if (PH == PH_NORM2) phase_norm(p, p.cross_norm + layer * D_);
  if (PH == PH_CQ) phase_cq(p, layer, smem, ctr);
  if (PH == PH_CROSS) phase_cross(p, smem, ctr);
  if (PH == PH_CO) phase_gemm_res(p, p.co, 512, p.wt_co, 512, p.out, smem, ctr);
  if (PH == PH_NORM3) phase_norm(p, p.ffn_norm + layer * D_);
  if (PH == PH_UP) phase_up(p, smem, ctr);
  if (PH == PH_CONV) phase_conv(p, layer, smem, ctr);
  if (PH == PH_DOWN) phase_gemm_res(p, p.act, DFF, p.wt_down, DFF, p.out, smem, ctr);
}


#define XB_TMO      128
#define XB_XCNT(j)  (256  + 64 * (j))
#define XB_XSUB(j)  (1280 + 64 * (j))
#define XB_XGEN(j)  (2304 + 64 * (j))
#define XB_TOP      3328
#define XB_TOPGEN   3392
#define XCD_BAR_WORDS 3456
#define XB_SPIN_CAP (1u << 20)
DI unsigned xb_ld(unsigned* p) { return __hip_atomic_load(p, __ATOMIC_RELAXED, __HIP_MEMORY_SCOPE_AGENT); }
DI unsigned xb_add(unsigned* p, unsigned v) { return __hip_atomic_fetch_add(p, v, __ATOMIC_RELAXED, __HIP_MEMORY_SCOPE_AGENT); }
DI unsigned xb_xcc_id() { return (unsigned)__builtin_amdgcn_s_getreg((3 << 11) | 20) & 0xFu; }
#define XB_SPIN(cond, bar) do { unsigned _sp = 0; while (cond) { __builtin_amdgcn_s_sleep(1); \
    if ((++_sp & 255u) == 0u) { if (xb_ld(&(bar)[XB_TMO])) break; if (_sp > XB_SPIN_CAP) { atomicAdd(&(bar)[XB_TMO], 1u); break; } } } } while (0)

DI void xb_init(unsigned* bar) {
  const int t = __builtin_amdgcn_workitem_id_x();
  if (t == 0) {
    const unsigned x = xb_xcc_id();
    (void)xb_add(&bar[XB_XCNT(x)], 1u);
    const unsigned G = gridDim.x;
    unsigned sum, cnt, mine, sp = 0u;
    for (;;) {
      sum = 0u; cnt = 0u; mine = 0u;
#pragma unroll
      for (unsigned j = 0; j < 16; ++j) { const unsigned c = xb_ld(&bar[XB_XCNT(j)]); sum += c; cnt += (c > 0u) ? 1u : 0u; mine = (j == x) ? c : mine; }
      if (sum == G) break;
      __builtin_amdgcn_s_sleep(1);
      if ((++sp & 255u) == 0u) { if (xb_ld(&bar[XB_TMO])) break; if (sp > XB_SPIN_CAP) { atomicAdd(&bar[XB_TMO], 1u); break; } }
    }
    const int bid = lbid();
    bar[XCD_BAR_WORDS + 2 * bid] = mine > 0u ? mine : 1u;
    bar[XCD_BAR_WORDS + 2 * bid + 1] = cnt > 0u ? cnt : 1u;
  }
  __syncthreads();
}

DI void xcd_barrier(unsigned* bar) {
  asm volatile("s_waitcnt vmcnt(0)" ::: "memory");
  __syncthreads();
  if (__builtin_amdgcn_workitem_id_x() == 0) {
    __builtin_amdgcn_s_waitcnt(0);
    const unsigned x = xb_xcc_id();
    const int bid = lbid();
    const unsigned nloc = bar[XCD_BAR_WORDS + 2 * bid], nx = bar[XCD_BAR_WORDS + 2 * bid + 1];
    const unsigned old = xb_add(&bar[XB_XSUB(x)], 1u);
    const unsigned gen = old / nloc;
    if (old + 1u == (gen + 1u) * nloc) {
      __builtin_amdgcn_fence(__ATOMIC_RELEASE, "agent");
      asm volatile("s_waitcnt vmcnt(0)" ::: "memory");
      const unsigned og = xb_add(&bar[XB_TOP], 1u);
      const unsigned tg = og / nx;
      if (og + 1u == (tg + 1u) * nx) xb_add(&bar[XB_TOPGEN], 1u);
      else XB_SPIN(xb_ld(&bar[XB_TOPGEN]) == tg, bar);
      __builtin_amdgcn_fence(__ATOMIC_ACQUIRE, "agent");
      xb_add(&bar[XB_XGEN(x)], 1u);
      asm volatile("s_waitcnt vmcnt(0)" ::: "memory");
    } else {
      XB_SPIN(xb_ld(&bar[XB_XGEN(x)]) == gen, bar);
      __builtin_amdgcn_fence(__ATOMIC_ACQUIRE, "agent");
      asm volatile("s_waitcnt vmcnt(0)" ::: "memory");
    }
  }
  __syncthreads();
}

typedef const Params __attribute__((address_space(4)))* CP4;
DI const Params& launder() {
  CP4 q = (CP4)__builtin_amdgcn_kernarg_segment_ptr();
  asm volatile("" : "+s"(q));
  return *(const Params*)q;
}

#if MULTI
template <int PH>
__global__ void __launch_bounds__(NTHR, 2) phase_kernel(Params p, int layer) {
  __shared__ __attribute__((aligned(16))) unsigned char smem[65536];
  run_phase<PH>(p, layer, smem);
}
#else
__global__ void __launch_bounds__(NTHR, 2) mega_kernel(Params p) {
  __shared__ __attribute__((aligned(16))) unsigned char smem[65536];
  cg::grid_group grid = cg::this_grid();
  xb_init(launder().bar);
#define SEAM() xcd_barrier(launder().bar)
#pragma unroll 1
  for (int layer = 0; layer < 2; ++layer) {
    run_phase<PH_PREP>(launder(), layer, smem);
    SEAM();
    if (launder().counters == nullptr) grid.sync();
    run_phase<PH_WIN>(launder(), layer, smem); SEAM();
    run_phase<PH_MIX1>(launder(), layer, smem); SEAM();
    run_phase<PH_MIX2>(launder(), layer, smem); SEAM();
    run_phase<PH_WOUT>(launder(), layer, smem); SEAM();
    run_phase<PH_NORM2>(launder(), layer, smem); SEAM();
    run_phase<PH_CQ>(launder(), layer, smem); SEAM();
    run_phase<PH_CO>(launder(), layer, smem); SEAM();
    run_phase<PH_NORM3>(launder(), layer, smem); SEAM();
    run_phase<PH_UP>(launder(), layer, smem); SEAM();
    run_phase<PH_CONV>(launder(), layer, smem); SEAM();
    run_phase<PH_DOWN>(launder(), layer, smem);
    if (layer == 0) SEAM();
  }
}
#endif

static size_t alignup(size_t v) { return (v + 255) & ~(size_t)255; }

extern "C" void kernel_launch(void* const* d_in, const int* in_sizes, int n_in, void* d_out, int out_size, void* d_ws, size_t ws_size,
                              hipStream_t stream) {
  Params p;
  memset(&p, 0, sizeof(p));
  p.x = (const float*)d_in[0]; p.mem = (const float*)d_in[1]; p.pos = (const int*)d_in[2];
  p.attn_norm = (const float*)d_in[3]; p.w_in = (const float*)d_in[4]; p.moba_g = (const float*)d_in[5];
  p.diff_g = (const float*)d_in[6]; p.diff_lam = (const float*)d_in[7]; p.diff_subln = (const float*)d_in[8];
  p.dsa_g = (const float*)d_in[9]; p.w_out = (const float*)d_in[10]; p.cross_norm = (const float*)d_in[11];
  p.mem_norm = (const float*)d_in[12]; p.cross_wq = (const float*)d_in[13]; p.cross_wkv = (const float*)d_in[14];
  p.cross_g = (const float*)d_in[15]; p.cross_wo = (const float*)d_in[16]; p.ffn_norm = (const float*)d_in[17];
  p.w_up = (const float*)d_in[18]; p.conv_w = (const float*)d_in[19]; p.conv_b = (const float*)d_in[20];
  p.w_down = (const float*)d_in[21];
  p.out = (float*)d_out;
  unsigned char* w = (unsigned char*)d_ws;
  size_t off = 0;
  auto take = [&](size_t bytes) { unsigned char* r = w + off; off += alignup(bytes); return r; };
  p.counters = (int*)take(10240);
  p.bar = (unsigned*)take((size_t)(XCD_BAR_WORDS + 2048) * 4);
  p.wt_in = (u16*)take((size_t)DINP * D_ * 2);
  p.wt_out = (u16*)take((size_t)D_ * D_ * 2);
  p.wt_cq = (u16*)take((size_t)512 * D_ * 2);
  p.wt_ckv = (u16*)take((size_t)1024 * D_ * 2);
  p.wt_co = (u16*)take((size_t)D_ * 512 * 2);
  p.wt_up = (u16*)take((size_t)DFF2 * D_ * 2);
  p.wt_down = (u16*)take((size_t)D_ * DFF * 2);
  p.ck = (u16*)take((size_t)MEML * 512 * 2);
  p.cvT = (u16*)take((size_t)4 * 128 * MEML * 2);
  p.mnorm = (u16*)take((size_t)MEML * D_ * 2);
  p.kbar = (float*)take((size_t)32 * 768 * 4);
  p.iw = (float*)take((size_t)S_ * 8 * 4);
  p.cq = (u16*)take((size_t)S_ * 512 * 2);
  p.co = (u16*)take((size_t)S_ * 512 * 2);
  const size_t ubase = off;
  p.proj = (u16*)take((size_t)S_ * DIN * 2);
  p.vT = (u16*)take((size_t)16 * 128 * S_ * 2);
  p.mixed = (u16*)take((size_t)S_ * D_ * 2);
  p.dmask = (u32*)take((size_t)S_ * 256 * 4);
  p.dscr = (float*)take((size_t)8 * S_ * 128 * 4);
  p.scores = (u32*)take((size_t)SEL_BLOCKS * 16 * 8192 * 4);
  p.hbuf = (u16*)p.scores;
  const size_t total = off;
  p.ubuf = (u16*)(w + ubase);
  p.act = (u16*)(w + ubase + alignup((size_t)S_ * DFF2 * 2));
  const size_t ubuf_end = ubase + alignup((size_t)S_ * DFF2 * 2);
  const size_t ffn_end = ubuf_end + alignup((size_t)S_ * DFF * 2);
  if ((size_t)((unsigned char*)p.hbuf - w) < ubuf_end || ffn_end > total || total > ws_size) {
    fprintf(stderr, "workspace layout problem: total %zu ws %zu\n", total, ws_size);
    return;
  }
  for (int i = 0; i < 64; ++i) p.inv128[i] = (float)pow(10000.0, -(double)(2 * i) / 128.0);
  for (int i = 0; i < 32; ++i) p.inv64[i] = (float)pow(10000.0, -(double)(2 * i) / 64.0);

  (void)hipMemsetAsync(p.counters, 0, 10240 + (size_t)XCD_BAR_WORDS * 4, stream);
#if MULTI
  const int grid = 512;
  for (int layer = 0; layer < 2; ++layer) {
    phase_kernel<PH_PREP><<<grid, NTHR, 0, stream>>>(p, layer);
    phase_kernel<PH_WIN><<<grid, NTHR, 0, stream>>>(p, layer);
    phase_kernel<PH_MIX1><<<grid, NTHR, 0, stream>>>(p, layer);
    phase_kernel<PH_MIX2><<<grid, NTHR, 0, stream>>>(p, layer);
    phase_kernel<PH_WOUT><<<grid, NTHR, 0, stream>>>(p, layer);
    phase_kernel<PH_NORM2><<<grid, NTHR, 0, stream>>>(p, layer);
    phase_kernel<PH_CQ><<<grid, NTHR, 0, stream>>>(p, layer);
    phase_kernel<PH_CROSS><<<grid, NTHR, 0, stream>>>(p, layer);
    phase_kernel<PH_CO><<<grid, NTHR, 0, stream>>>(p, layer);
    phase_kernel<PH_NORM3><<<grid, NTHR, 0, stream>>>(p, layer);
    phase_kernel<PH_UP><<<grid, NTHR, 0, stream>>>(p, layer);
    phase_kernel<PH_CONV><<<grid, NTHR, 0, stream>>>(p, layer);
    phase_kernel<PH_DOWN><<<grid, NTHR, 0, stream>>>(p, layer);
  }
#else
  static int grid_blocks = 0;
  if (!grid_blocks) {
    int dev = 0, cus = 0, per_cu = 0;
    hipGetDevice(&dev);
    hipDeviceGetAttribute(&cus, hipDeviceAttributeMultiprocessorCount, dev);
    hipOccupancyMaxActiveBlocksPerMultiprocessor(&per_cu, mega_kernel, NTHR, 0);
    if (per_cu > 2) per_cu = 2;
    grid_blocks = cus * per_cu;
  }
  void* args[] = {&p};
  hipError_t e = hipLaunchCooperativeKernel((void*)mega_kernel, dim3(grid_blocks), dim3(NTHR), args, 0, stream);
  if (e != hipSuccess) fprintf(stderr, "cooperative launch failed: %s (grid %d)\n", hipGetErrorString(e), grid_blocks);
#endif
}
```

```cpp
#include <hip/hip_runtime.h>
#include <hip/hip_cooperative_groups.h>
#include <stdint.h>
#include <math.h>
#include <stdio.h>
#include <string.h>
namespace cg = cooperative_groups;

#ifndef MULTI
#define MULTI 0
#endif

typedef unsigned short u16;
typedef unsigned int u32;
typedef unsigned long long u64;
using bf16x8 = __attribute__((ext_vector_type(8))) short;
using s16x4 = __attribute__((ext_vector_type(4))) short;
using f32x16 = __attribute__((ext_vector_type(16))) float;
using f32x4 = __attribute__((ext_vector_type(4))) float;
using u32x4 = __attribute__((ext_vector_type(4))) unsigned;
using u32x2 = __attribute__((ext_vector_type(2))) unsigned;
typedef __bf16 bf2_t __attribute__((ext_vector_type(2)));
typedef float f2_t __attribute__((ext_vector_type(2)));
#define DI __device__ __forceinline__
#define NEG_INF (-__builtin_inff())

constexpr int S_ = 8192, D_ = 2048, DIN = 6728, DINP = 6784, DFF = 5504, DFF2 = 11008, MEML = 256;
constexpr int C_MQ = 0, C_MK = 768, C_MV = 1536, C_DQ = 2304, C_DK = 2816, C_DV = 3328, C_SQ = 3840, C_SK = 4608, C_SV = 5376,
              C_IQ = 6144, C_IK = 6656, C_IW = 6720;
constexpr int NTHR = 256;
constexpr int SEL_BLOCKS = 256;

struct Params {
  const float *x, *mem; const int* pos;
  const float *attn_norm, *w_in, *moba_g, *diff_g, *diff_lam, *diff_subln, *dsa_g, *w_out, *cross_norm, *mem_norm, *cross_wq,
      *cross_wkv, *cross_g, *cross_wo, *ffn_norm, *w_up, *conv_w, *conv_b, *w_down;
  float* out;
  u16 *wt_in, *wt_out, *wt_cq, *wt_ckv, *wt_co, *wt_up, *wt_down;
  u16 *hbuf, *proj, *vT, *mixed, *cq, *co, *ck, *cvT, *mnorm, *ubuf, *act;
  u32 *dmask, *scores; float *kbar, *iw, *dscr; int* counters; unsigned* bar;
  float inv128[64]; float inv64[32];
};

DI u32 pack2(float a, float b) { f2_t v = {a, b}; return __builtin_bit_cast(u32, __builtin_convertvector(v, bf2_t)); }
DI float bflo(u32 w) { return __uint_as_float(w << 16); }
DI float bfhi(u32 w) { return __uint_as_float(w & 0xffff0000u); }
DI int crow(int i, int h) { return (i & 3) + 8 * (i >> 2) + 4 * h; }
DI f32x16 mfma32(bf16x8 a, bf16x8 b, f32x16 c) { return __builtin_amdgcn_mfma_f32_32x32x16_bf16(a, b, c, 0, 0, 0); }
DI f32x4 mfma16(bf16x8 a, bf16x8 b, f32x4 c) { return __builtin_amdgcn_mfma_f32_16x16x32_bf16(a, b, c, 0, 0, 0); }
DI int ltid() { int t = __builtin_amdgcn_workitem_id_x(); asm volatile("" : "+v"(t)); return t; }
DI int lbid() { int b = __builtin_amdgcn_workgroup_id_x(); asm volatile("" : "+s"(b)); return b; }
DI void dma16(const void* g, void* l) { __builtin_amdgcn_global_load_lds((const unsigned*)g, (unsigned*)l, 16, 0, 0); }
DI float wave_sum(float v) {
#pragma unroll
  for (int o = 32; o >= 1; o >>= 1) v += __shfl_xor(v, o);
  return v;
}

DI int next_item(int* counter, unsigned char* smem) {
  __syncthreads();
  if (ltid() == 0) { ((int*)smem)[0] = atomicAdd(counter, 1); ((u32*)smem)[1] = 0u; }
  __syncthreads();
  const int it = ((volatile int*)smem)[0];
  __syncthreads();
  return it;
}

DI void convert_tile(const float* __restrict__ W, int K, int N, u16* __restrict__ Wt, int kt, int nt, float* tl) {
  const int tid = ltid(), ty = tid >> 5, tx = tid & 31;
  const int k0 = kt * 64, n0 = nt * 128;
  float4 v[8];
#pragma unroll
  for (int i = 0; i < 8; ++i) {
    const int k = k0 + ty + 8 * i, n = n0 + 4 * tx;
    v[i] = make_float4(0.f, 0.f, 0.f, 0.f);
    if (n < N) v[i] = *(const float4*)(W + (size_t)k * N + n);
  }
#pragma unroll
  for (int i = 0; i < 8; ++i) {
    float* d = tl + (ty + 8 * i) * 129 + 4 * tx;
    d[0] = v[i].x; d[1] = v[i].y; d[2] = v[i].z; d[3] = v[i].w;
  }
  __syncthreads();
  {
    const int n = tid >> 1, kc = tid & 1;
    u32 w[16];
#pragma unroll
    for (int j = 0; j < 16; ++j) w[j] = pack2(tl[(kc * 32 + 2 * j) * 129 + n], tl[(kc * 32 + 2 * j + 1) * 129 + n]);
    uint4* dst = (uint4*)(Wt + (size_t)(n0 + n) * K + k0 + kc * 32);
#pragma unroll
    for (int j = 0; j < 4; ++j) dst[j] = make_uint4(w[4 * j], w[4 * j + 1], w[4 * j + 2], w[4 * j + 3]);
  }
  __syncthreads();
}

DI void rownorm(const float* __restrict__ x, const float* __restrict__ g, u16* __restrict__ out, int row) {
  const int lane = ltid() & 63;
  const float4* xr = (const float4*)(x + (size_t)row * D_);
  float4 v[8];
  float ss = 0.f;
#pragma unroll
  for (int i = 0; i < 8; ++i) {
    v[i] = xr[lane + 64 * i];
    ss += v[i].x * v[i].x + v[i].y * v[i].y + v[i].z * v[i].z + v[i].w * v[i].w;
  }
  ss = wave_sum(ss);
  const float rs = rsqrtf(ss * (1.0f / D_) + 1e-6f);
  uint2* o = (uint2*)(out + (size_t)row * D_);
#pragma unroll
  for (int i = 0; i < 8; ++i) {
    float4 gg = ((const float4*)g)[lane + 64 * i];
    o[lane + 64 * i] = make_uint2(pack2(v[i].x * rs * gg.x, v[i].y * rs * gg.y), pack2(v[i].z * rs * gg.z, v[i].w * rs * gg.w));
  }
}

enum { K_NR128 = 0, K_NR64, K_R64, K_VT, K_IKIW, K_N128, K_RAW };
struct EpiStage {
  int kind; const float* gain; u16* out; int ldo; int col; u16* vt; int vtS;
};

DI void rope_cs(float posf, float inv, float& c, float& s) {
  double rev = (double)posf * (double)inv * 0.15915494309189535;
  rev = rev - floor(rev);
  float fr = (float)rev;
  s = __builtin_amdgcn_sinf(fr);
  c = __builtin_amdgcn_cosf(fr);
}

DI void epi_rows(const Params& p, const float* cs, const EpiStage& es, int mrow0) {
  const int tid = ltid();
  if (es.kind == K_VT) {
    const int c = tid >> 1, rh = tid & 1;
    u32 w[16];
#pragma unroll
    for (int j = 0; j < 16; ++j) w[j] = pack2(cs[(32 * rh + 2 * j) * 132 + c], cs[(32 * rh + 2 * j + 1) * 132 + c]);
    uint4* dst = (uint4*)(es.vt + (size_t)c * es.vtS + mrow0 + 32 * rh);
    dst[0] = make_uint4(w[0], w[1], w[4], w[5]);
    dst[1] = make_uint4(w[2], w[3], w[6], w[7]);
    dst[2] = make_uint4(w[8], w[9], w[12], w[13]);
    dst[3] = make_uint4(w[10], w[11], w[14], w[15]);
    return;
  }
  const int r = tid >> 2, qd = tid & 3;
  const int m = mrow0 + r;
  const float* cr = cs + r * 132;
  if (es.kind == K_RAW) {
    u32 w[16];
#pragma unroll
    for (int j = 0; j < 8; ++j) {
      float4 v = *(const float4*)(cr + 32 * qd + 4 * j);
      w[2 * j] = pack2(v.x, v.y); w[2 * j + 1] = pack2(v.z, v.w);
    }
    uint4* dst = (uint4*)(es.out + (size_t)m * es.ldo + es.col + 32 * qd);
#pragma unroll
    for (int j = 0; j < 4; ++j) dst[j] = make_uint4(w[4 * j], w[4 * j + 1], w[4 * j + 2], w[4 * j + 3]);
    return;
  }
  const bool d64 = !(es.kind == K_NR128 || es.kind == K_N128);
  const int hd = d64 ? (qd >> 1) : 0, sub = d64 ? (qd & 1) : qd, half = d64 ? 32 : 64;
  const int cl = hd * 64 + sub * 16, ch = cl + half;
  float lo[16], hi[16];
#pragma unroll
  for (int j = 0; j < 4; ++j) {
    float4 a = *(const float4*)(cr + cl + 4 * j), b = *(const float4*)(cr + ch + 4 * j);
    lo[4 * j] = a.x; lo[4 * j + 1] = a.y; lo[4 * j + 2] = a.z; lo[4 * j + 3] = a.w;
    hi[4 * j] = b.x; hi[4 * j + 1] = b.y; hi[4 * j + 2] = b.z; hi[4 * j + 3] = b.w;
  }
  float ss = 0.f;
#pragma unroll
  for (int j = 0; j < 16; ++j) ss += lo[j] * lo[j] + hi[j] * hi[j];
  ss += __shfl_xor(ss, 1);
  const float ss2 = ss + __shfl_xor(ss, 2);
  if (!d64) ss = ss2;
  const bool donorm = (es.kind == K_NR128 || es.kind == K_NR64 || es.kind == K_N128);
  if (donorm) {
    const float rs = rsqrtf(ss * (d64 ? (1.0f / 64) : (1.0f / 128)) + 1e-6f);
#pragma unroll
    for (int j = 0; j < 16; ++j) {
      lo[j] *= rs * es.gain[sub * 16 + j];
      hi[j] *= rs * es.gain[sub * 16 + j + half];
    }
  }
  if (es.kind != K_N128) {
    const float posf = (float)p.pos[m];
#pragma unroll
    for (int j = 0; j < 16; ++j) {
      const int i = sub * 16 + j;
      const float inv = d64 ? p.inv64[i] : p.inv128[i];
      float c, s;
      rope_cs(posf, inv, c, s);
      const float a = lo[j], b = hi[j];
      lo[j] = a * c - b * s;
      hi[j] = b * c + a * s;
    }
  }
  if (es.kind == K_IKIW) {
    if (qd == 2) {
      float4 a = *(const float4*)(cr + 64), b = *(const float4*)(cr + 68);
      float4* d = (float4*)(p.iw + (size_t)m * 8);
      d[0] = a; d[1] = b;
    }
    if (qd >= 2) return;
  }
  u16* orow = es.out + (size_t)m * es.ldo + es.col;
  uint4* d0 = (uint4*)(orow + cl);
  uint4* d1 = (uint4*)(orow + ch);
  d0[0] = make_uint4(pack2(lo[0], lo[1]), pack2(lo[2], lo[3]), pack2(lo[4], lo[5]), pack2(lo[6], lo[7]));
  d0[1] = make_uint4(pack2(lo[8], lo[9]), pack2(lo[10], lo[11]), pack2(lo[12], lo[13]), pack2(lo[14], lo[15]));
  d1[0] = make_uint4(pack2(hi[0], hi[1]), pack2(hi[2], hi[3]), pack2(hi[4], hi[5]), pack2(hi[6], hi[7]));
  d1[1] = make_uint4(pack2(hi[8], hi[9]), pack2(hi[10], hi[11]), pack2(hi[12], hi[13]), pack2(hi[14], hi[15]));
}

template <int EPI>
DI void gemm_tile(const Params& p, const u16* __restrict__ A, int lda, const u16* __restrict__ Bt, int ldb, int K, int m0, int n0,
                  unsigned char* smem, const EpiStage& es, const float* res, float* outp) {
  const int tid = ltid(), lane = tid & 63, wid = tid >> 6, wm = wid >> 1, wn = wid & 1;
  const int lr = lane & 31, lh = lane >> 5;
  f32x16 acc[2][2];
#pragma unroll
  for (int a = 0; a < 2; ++a)
#pragma unroll
    for (int b = 0; b < 2; ++b)
#pragma unroll
      for (int i = 0; i < 16; ++i) acc[a][b][i] = 0.f;

  const u16* Ag = A + (size_t)(m0 + (tid >> 3)) * lda + (((tid & 7) ^ ((tid >> 4) & 7)) << 3);
  const u16* Bg = Bt + (size_t)(n0 + (tid >> 3)) * ldb + (((tid & 7) ^ ((tid >> 4) & 7)) << 3);
  const int wofs = tid * 16;
  const int sw = (lr >> 1) & 7;
  const int aofs = (wm * 64 + lr) * 128, bofs = 16384 + (wn * 64 + lr) * 128;
  const int nk = K >> 6;
#define G_DMA(BUF, KT) _Pragma("unroll") for (int i = 0; i < 4; ++i) { \
    dma16(Ag + (size_t)(32 * i) * lda + (KT) * 64, smem + (BUF) * 32768 + wofs + i * 4096); \
    dma16(Bg + (size_t)(32 * i) * ldb + (KT) * 64, smem + (BUF) * 32768 + 16384 + wofs + i * 4096); }
#define G_LANDED() asm volatile("s_waitcnt vmcnt(0)" ::: "memory")
#define G_COMPUTE(BUF, DMA_STMT) { const unsigned char* sb = smem + (BUF) * 32768; \
    bf16x8 fa0[4], fa1[4], fb0[4], fb1[4]; \
    _Pragma("unroll") for (int ks = 0; ks < 4; ++ks) { \
      const int co = ((2 * ks + lh) ^ sw) << 4; \
      fa0[ks] = *(const bf16x8*)(sb + aofs + co); \
      fb0[ks] = *(const bf16x8*)(sb + bofs + co); \
      fa1[ks] = *(const bf16x8*)(sb + aofs + 4096 + co); \
      fb1[ks] = *(const bf16x8*)(sb + bofs + 4096 + co); } \
    __builtin_amdgcn_sched_barrier(0); \
    DMA_STMT; \
    __builtin_amdgcn_sched_barrier(0); \
    _Pragma("unroll") for (int ks = 0; ks < 4; ++ks) { \
      acc[0][0] = mfma32(fa0[ks], fb0[ks], acc[0][0]); \
      acc[0][1] = mfma32(fa0[ks], fb1[ks], acc[0][1]); \
      acc[1][0] = mfma32(fa1[ks], fb0[ks], acc[1][0]); \
      acc[1][1] = mfma32(fa1[ks], fb1[ks], acc[1][1]); } \
    __builtin_amdgcn_sched_barrier(0); }
  G_DMA(0, 0);
  G_LANDED();
  __syncthreads();
  for (int kt = 0; kt < nk; kt += 2) {
    G_COMPUTE(0, G_DMA(1, kt + 1));
    G_LANDED();
    __syncthreads();
    const int kl = (kt + 2 < nk) ? kt + 2 : nk - 1;
    G_COMPUTE(1, G_DMA(0, kl));
    G_LANDED();
    __syncthreads();
  }
#undef G_DMA
#undef G_LANDED
#undef G_COMPUTE
  if (EPI == 1) {
#pragma unroll
    for (int mb = 0; mb < 2; ++mb)
#pragma unroll
      for (int nb = 0; nb < 2; ++nb)
#pragma unroll
        for (int i = 0; i < 16; ++i) {
          const size_t idx = (size_t)(m0 + wm * 64 + mb * 32 + crow(i, lh)) * D_ + n0 + wn * 64 + nb * 32 + lr;
          outp[idx] = res[idx] + acc[mb][nb][i];
        }
  } else {
    float* cs = (float*)smem;
#pragma unroll
    for (int ps = 0; ps < 2; ++ps) {
      if (wm == ps) {
#pragma unroll
        for (int mb = 0; mb < 2; ++mb)
#pragma unroll
          for (int nb = 0; nb < 2; ++nb)
#pragma unroll
            for (int i = 0; i < 16; ++i) cs[(mb * 32 + crow(i, lh)) * 132 + wn * 64 + nb * 32 + lr] = acc[mb][nb][i];
      }
      __syncthreads();
      epi_rows(p, cs, es, m0 + 64 * ps);
      __syncthreads();
    }
  }
}

template <int DQK, int MODE, int ldq, int ldk, int ldv>
DI void attn_core(const u16* __restrict__ Q, const u16* __restrict__ Kp, const u16* __restrict__ Vt, int q0,
                  int kt_lo, int nkt, float sc2, const u32* __restrict__ dmask, const float* __restrict__ kbar_h, unsigned char* smem,
                  f32x16 (&O)[4], float& l_out, float& m_out) {
  constexpr int NKS = DQK / 16, RB = DQK * 2, CPR = RB / 16, KCH = 64 * CPR / NTHR;
  const int tid = ltid(), lane = tid & 63, wid = tid >> 6, lr = lane & 31, lh = lane >> 5;
  const int qw0 = q0 + 32 * wid, q = qw0 + lr;
  const int cur = q0 >> 8;
  bf16x8 qf[NKS];
  if (MODE != 2) {
#pragma unroll
    for (int ks = 0; ks < NKS; ++ks) qf[ks] = *(const bf16x8*)(Q + (size_t)q * ldq + ks * 16 + lh * 8);
  }
  float m = -1e30f, l = 0.f;
  u32 selw = 0, un = 0xffffffffu;
  if (MODE == 2) {
    f32x16 G;
#pragma unroll
    for (int i = 0; i < 16; ++i) G[i] = 0.f;
    bf16x8 gq[8];
#pragma unroll
    for (int ks = 0; ks < 8; ++ks) gq[ks] = *(const bf16x8*)(Q + (size_t)q * ldq + ks * 16 + lh * 8);
#pragma unroll
    for (int ks = 0; ks < 8; ++ks) {
      const float* kp = kbar_h + (size_t)lr * 768 + ks * 16 + lh * 8;
      float4 a = *(const float4*)kp, b = *(const float4*)(kp + 4);
      u32 h0 = pack2(a.x, a.y), h1 = pack2(a.z, a.w), h2 = pack2(b.x, b.y), h3 = pack2(b.z, b.w);
      u32 l0 = pack2(a.x - bflo(h0), a.y - bfhi(h0)), l1 = pack2(a.z - bflo(h1), a.w - bfhi(h1));
      u32 l2 = pack2(b.x - bflo(h2), b.y - bfhi(h2)), l3 = pack2(b.z - bflo(h3), b.w - bfhi(h3));
      u32x4 hv = {h0, h1, h2, h3}, lv = {l0, l1, l2, l3};
      G = mfma32(__builtin_bit_cast(bf16x8, hv), gq[ks], G);
      G = mfma32(__builtin_bit_cast(bf16x8, lv), gq[ks], G);
      if ((ks & 1) == 1) __builtin_amdgcn_sched_barrier(0);
    }
    float b0 = NEG_INF, b1 = NEG_INF, b2 = NEG_INF;
    int i0 = 0, i1 = 0, i2 = 0;
#pragma unroll
    for (int ig = 0; ig < 4; ++ig) {
#pragma unroll
      for (int hh = 0; hh < 2; ++hh) {
#pragma unroll
        for (int j = 0; j < 4; ++j) {
          const int i = 4 * ig + j;
          const float o = __shfl_xor(G[i], 32);
          const int n = 8 * ig + 4 * hh + j;
          float v = (hh == lh) ? G[i] : o;
          v = (n < cur) ? v : NEG_INF;
          const bool g0 = v > b0, g1 = v > b1, g2 = v > b2;
          b2 = g1 ? b1 : (g2 ? v : b2); i2 = g1 ? i1 : (g2 ? n : i2);
          b1 = g0 ? b0 : (g1 ? v : b1); i1 = g0 ? i0 : (g1 ? n : i1);
          b0 = g0 ? v : b0;             i0 = g0 ? n : i0;
        }
      }
    }
    if (b0 > NEG_INF) selw |= 1u << i0;
    if (b1 > NEG_INF) selw |= 1u << i1;
    if (b2 > NEG_INF) selw |= 1u << i2;
    atomicOr(((u32*)smem) + 1, selw);
    __syncthreads();
    un = ((volatile u32*)smem)[1];
    __syncthreads();
    {
      const u16* Q2 = Q + (size_t)q * ldq + lh * 8;
      asm volatile("" : "+v"(Q2));
#pragma unroll
      for (int ks = 0; ks < NKS; ++ks) qf[ks] = *(const bf16x8*)(Q2 + ks * 16);
    }
  }

#pragma unroll
  for (int b = 0; b < 4; ++b)
#pragma unroll
    for (int i = 0; i < 16; ++i) O[b][i] = 0.f;
  const int swzK = (DQK == 128) ? (lr & 15) : ((lr >> 1) & 7);
  const int vsw = (lr >> 1) & 7;
  constexpr int RPI = NTHR / CPR;
  const int kr0 = tid / CPR, kch = tid % CPR;
  const int kszw = (DQK == 128) ? (kr0 & 15) : ((kr0 >> 1) & 7);
  const int kwofs = kr0 * RB + (kch << 4);
  const int klane = kr0 * ldk + ((kch ^ kszw) << 3);
  const int vr0 = tid >> 3, vch = tid & 7, vszw = (vr0 >> 1) & 7;
  const int vwofs = 16384 + vr0 * 128 + (vch << 4);
  const int vlane = vr0 * ldv + ((vch ^ vszw) << 3);
  u32x2 mw = {0u, 0u}, mwn = {0u, 0u};

  int kt = kt_lo;
  if (MODE == 2) { while (kt < nkt && !((kt >> 2) == cur || ((un >> (kt >> 2)) & 1))) ++kt; }
  {
    const int kp = (kt < nkt) ? kt : nkt - 1;
#pragma unroll
    for (int i = 0; i < KCH; ++i) dma16(Kp + (size_t)(kp * 64 + i * RPI) * ldk + klane, smem + kwofs + i * (RPI * RB));
#pragma unroll
    for (int i = 0; i < 4; ++i) dma16(Vt + (size_t)(i * 32) * ldv + kp * 64 + vlane, smem + vwofs + i * 4096);
    if (MODE == 3 && q0 >= 256) mw = *(const u32x2*)(dmask + (size_t)q * 256 + (kp * 2));
  }
  asm volatile("s_waitcnt vmcnt(0)" ::: "memory");
  __syncthreads();
  int buf = 0;
#pragma clang loop unroll(disable)
  while (kt < nkt) {
    int nx = kt + 1;
    if (MODE == 2) { while (nx < nkt && !((nx >> 2) == cur || ((un >> (nx >> 2)) & 1))) ++nx; }
    const bool more = nx < nkt;
    unsigned char* sn = smem + (buf ^ 1) * 32768;
    const int k0 = kt * 64;
    const bool active = (MODE == 0) || (k0 <= qw0 + 31);
    const unsigned char* kb = smem + buf * 32768;
    const unsigned char* vb = kb + 16384;
#pragma unroll
    for (int sub = 0; sub < 2; ++sub) {
      if (active) {
        f32x16 Sx;
#pragma unroll
        for (int i = 0; i < 16; ++i) Sx[i] = 0.f;
#pragma unroll
        for (int kh = 0; kh < NKS; kh += 4) {
          bf16x8 kf[4];
#pragma unroll
          for (int ks = 0; ks < 4; ++ks) kf[ks] = *(const bf16x8*)(kb + (32 * sub + lr) * RB + (((2 * (kh + ks) + lh) ^ swzK) << 4));
          __builtin_amdgcn_sched_barrier(0);
#pragma unroll
          for (int ks = 0; ks < 4; ++ks) Sx = mfma32(kf[ks], qf[kh + ks], Sx);
        }
        bf16x8 vf0[4], vf1[4];
        {
          const int c16 = 4 * sub + lh;
#pragma unroll
          for (int b = 0; b < 4; ++b) vf0[b] = *(const bf16x8*)(vb + (32 * b + lr) * 128 + ((c16 ^ vsw) << 4));
        }
        __builtin_amdgcn_sched_barrier(0);
        float mx = fmaxf(fmaxf(Sx[0], Sx[1]), fmaxf(Sx[2], Sx[3]));
#pragma unroll
        for (int i = 4; i < 16; i += 2) mx = fmaxf(mx, fmaxf(Sx[i], Sx[i + 1]));
        mx = fmaxf(mx, __shfl_xor(mx, 32));
        const float mnew = fmaxf(m, mx);
        const float alpha = __builtin_amdgcn_exp2f((m - mnew) * sc2);
        m = mnew;
        float negm = -mnew * sc2;
        if (MODE == 2) { const int b = k0 >> 8; if (b != cur && !((selw >> b) & 1)) negm = NEG_INF; }
#pragma unroll
        for (int i = 0; i < 16; ++i) Sx[i] = __builtin_amdgcn_exp2f(__builtin_fmaf(Sx[i], sc2, negm));
        if (MODE == 3 && q0 >= 256) {
          const u32 wsh = (sub ? mw.y : mw.x) >> (4 * lh);
#pragma unroll
          for (int i = 0; i < 16; ++i) {
            const int t = __builtin_amdgcn_sbfe((int)wsh, (i & 3) + 8 * (i >> 2), 1);
            Sx[i] = __uint_as_float(__float_as_uint(Sx[i]) & (u32)t);
          }
        } else if (MODE != 0) {
          if (k0 + 32 * sub + 31 > qw0) {
            const int thr = q - k0 - 32 * sub - 4 * lh;
#pragma unroll
            for (int i = 0; i < 16; ++i) Sx[i] = (((i & 3) + 8 * (i >> 2)) > thr) ? 0.f : Sx[i];
          }
        }
        float ls = 0.f;
#pragma unroll
        for (int i = 0; i < 16; ++i) ls += Sx[i];
        l = l * alpha + ls;
        if (__ballot(alpha != 1.0f) != 0ull) {
#pragma unroll
          for (int b = 0; b < 4; ++b)
#pragma unroll
            for (int i = 0; i < 16; ++i) O[b][i] *= alpha;
        }
        {
          const int c16 = 4 * sub + 2 + lh;
#pragma unroll
          for (int b = 0; b < 4; ++b) vf1[b] = *(const bf16x8*)(vb + (32 * b + lr) * 128 + ((c16 ^ vsw) << 4));
        }
        __builtin_amdgcn_sched_barrier(0);
        {
          u32x4 pw = {pack2(Sx[0], Sx[1]), pack2(Sx[2], Sx[3]), pack2(Sx[4], Sx[5]), pack2(Sx[6], Sx[7])};
          const bf16x8 pf = __builtin_bit_cast(bf16x8, pw);
#pragma unroll
          for (int b = 0; b < 4; ++b) O[b] = mfma32(vf0[b], pf, O[b]);
        }
        {
          u32x4 pw = {pack2(Sx[8], Sx[9]), pack2(Sx[10], Sx[11]), pack2(Sx[12], Sx[13]), pack2(Sx[14], Sx[15])};
          const bf16x8 pf = __builtin_bit_cast(bf16x8, pw);
#pragma unroll
          for (int b = 0; b < 4; ++b) O[b] = mfma32(vf1[b], pf, O[b]);
        }
      }
      if (sub == 0 && more) {
#pragma unroll
        for (int i = 0; i < KCH; ++i) dma16(Kp + (size_t)(nx * 64 + i * RPI) * ldk + klane, sn + kwofs + i * (RPI * RB));
#pragma unroll
        for (int i = 0; i < 4; ++i) dma16(Vt + (size_t)(i * 32) * ldv + nx * 64 + vlane, sn + vwofs + i * 4096);
        if (MODE == 3 && q0 >= 256) mwn = *(const u32x2*)(dmask + (size_t)q * 256 + (nx * 2));
      }
    }
    asm volatile("s_waitcnt vmcnt(0)" ::: "memory");
    __syncthreads();
    mw = mwn;
    kt = nx;
    buf ^= 1;
  }
  l_out = l + __shfl_xor(l, 32);
  m_out = m;
}

DI void write_O_bf16(const f32x16 (&O)[4], float linv, u16* __restrict__ out, int ldo, int q) {
  const int lh = (ltid() & 63) >> 5;
#pragma unroll
  for (int b = 0; b < 4; ++b)
#pragma unroll
    for (int g = 0; g < 4; ++g) {
      uint2 w = make_uint2(pack2(O[b][4 * g] * linv, O[b][4 * g + 1] * linv), pack2(O[b][4 * g + 2] * linv, O[b][4 * g + 3] * linv));
      *(uint2*)(out + (size_t)q * ldo + 32 * b + 8 * g + 4 * lh) = w;
    }
}

DI u32 f2key(float f) {
  u32 u = __float_as_uint(f + 0.0f);
  return (u & 0x80000000u) ? ~u : (u | 0x80000000u);
}
DI u32 ld_scr(const u32* p) { return __hip_atomic_load((u32*)p, __ATOMIC_RELAXED, __HIP_MEMORY_SCOPE_AGENT); }

DI void radix_extract(const u32* hrow, int lane, int& kneed, u32& digit_out) {
  int cnt[32];
#pragma unroll
  for (int j = 0; j < 4; ++j) {
    const uint4 v = ((const uint4*)hrow)[lane * 4 + j];
    cnt[8 * j + 0] = (int)(v.x & 0xffffu); cnt[8 * j + 1] = (int)(v.x >> 16);
    cnt[8 * j + 2] = (int)(v.y & 0xffffu); cnt[8 * j + 3] = (int)(v.y >> 16);
    cnt[8 * j + 4] = (int)(v.z & 0xffffu); cnt[8 * j + 5] = (int)(v.z >> 16);
    cnt[8 * j + 6] = (int)(v.w & 0xffffu); cnt[8 * j + 7] = (int)(v.w >> 16);
  }
  int local = 0;
#pragma unroll
  for (int j = 0; j < 32; ++j) local += cnt[j];
  int incl = local;
#pragma unroll
  for (int o = 1; o < 64; o <<= 1) {
    const int v = __shfl_down(incl, o);
    if (lane + o < 64) incl += v;
  }
  const int above = incl - local;
  const bool found = (above < kneed) && (kneed <= incl);
  int digit = 0, newk = 0;
  {
    int cum = above;
    bool done = false;
#pragma unroll
    for (int b = 31; b >= 0; --b) {
      if (!done && cum + cnt[b] >= kneed) { digit = 32 * lane + b; newk = kneed - cum; done = true; }
      cum += cnt[b];
    }
  }
  const u64 fm = __ballot(found);
  const int src = (int)__builtin_ctzll(fm);
  digit_out = (u32)__shfl(digit, src);
  kneed = __shfl(newk, src);
}

DI void dsa_select_item(const Params& p, int rb, unsigned char* smem) {
  const int tid = ltid(), lane = tid & 63, wid = tid >> 6, fr = lane & 15, fq = lane >> 4;
  const int t0 = rb * 16;
  u32* scr = p.scores + (size_t)blockIdx.x * (16 * 8192);
  u32* hist0 = (u32*)smem;
#pragma unroll
  for (int j = 0; j < 16; ++j) ((uint4*)hist0)[tid + 256 * j] = make_uint4(0, 0, 0, 0);
  __syncthreads();
  {
    const u16* iq = p.proj + C_IQ;
    const u16* ik = p.proj + C_IK;
    bf16x8 qa[8][2];
#pragma unroll
    for (int hd = 0; hd < 8; ++hd)
#pragma unroll
      for (int ks = 0; ks < 2; ++ks) qa[hd][ks] = *(const bf16x8*)(iq + (size_t)(t0 + fr) * DIN + hd * 64 + ks * 32 + fq * 8);
    float w[4][8];
#pragma unroll
    for (int j = 0; j < 4; ++j) {
      const float4* wp = (const float4*)(p.iw + (size_t)(t0 + 4 * fq + j) * 8);
      float4 a = wp[0], b = wp[1];
      w[j][0] = a.x; w[j][1] = a.y; w[j][2] = a.z; w[j][3] = a.w; w[j][4] = b.x; w[j][5] = b.y; w[j][6] = b.z; w[j][7] = b.w;
    }
    const int ntile = rb + 1, last = ntile - 1;
    bf16x8 c0, c1, a0, a1, b0, b1;
    {
      const int k0 = (wid < ntile ? wid : last) * 16, k1 = (wid + 4 < ntile ? wid + 4 : last) * 16, k2 = (wid + 8 < ntile ? wid + 8 : last) * 16;
      c0 = *(const bf16x8*)(ik + (size_t)(k0 + fr) * DIN + fq * 8); c1 = *(const bf16x8*)(ik + (size_t)(k0 + fr) * DIN + 32 + fq * 8);
      a0 = *(const bf16x8*)(ik + (size_t)(k1 + fr) * DIN + fq * 8); a1 = *(const bf16x8*)(ik + (size_t)(k1 + fr) * DIN + 32 + fq * 8);
      b0 = *(const bf16x8*)(ik + (size_t)(k2 + fr) * DIN + fq * 8); b1 = *(const bf16x8*)(ik + (size_t)(k2 + fr) * DIN + 32 + fq * 8);
    }
    for (int kt = wid; kt < ntile; kt += 4) {
      const int k0 = kt * 16;
      const bf16x8 kb0 = c0, kb1 = c1;
      c0 = a0; c1 = a1; a0 = b0; a1 = b1;
      {
        const int kn = (kt + 12 < ntile ? kt + 12 : last) * 16;
        b0 = *(const bf16x8*)(ik + (size_t)(kn + fr) * DIN + fq * 8);
        b1 = *(const bf16x8*)(ik + (size_t)(kn + fr) * DIN + 32 + fq * 8);
      }
      float sc[4] = {0.f, 0.f, 0.f, 0.f};
#pragma unroll
      for (int hd = 0; hd < 8; ++hd) {
        f32x4 c = {0.f, 0.f, 0.f, 0.f};
        c = mfma16(qa[hd][0], kb0, c);
        c = mfma16(qa[hd][1], kb1, c);
#pragma unroll
        for (int j = 0; j < 4; ++j) sc[j] += w[j][hd] * fmaxf(c[j], 0.f);
      }
#pragma unroll
      for (int j = 0; j < 4; ++j) {
        const int row = 4 * fq + j, key = k0 + fr;
        const bool adm = key <= t0 + row;
        const u32 kk = adm ? f2key(sc[j]) : 0u;
        scr[row * 8192 + key] = kk;
        if (adm) atomicAdd(&hist0[row * 1024 + (kk >> 22)], 1u << ((kk >> 17) & 16u));
      }
    }
  }
  asm volatile("s_waitcnt vmcnt(0)" ::: "memory");
  __syncthreads();
  __builtin_amdgcn_fence(__ATOMIC_ACQUIRE, "agent");
  u32* hist = (u32*)smem + wid * 4096;
  const int rowb = 4 * wid;
  const u32* sr0 = scr + rowb * 8192;
  const int nbase = t0 + rowb + 1;
  const int nmax = nbase + 3;
  u32 prefix[4] = {0u, 0u, 0u, 0u};
  int kneed[4] = {256, 256, 256, 256};
#pragma unroll
  for (int rr = 0; rr < 4; ++rr) { u32 d; radix_extract(hist0 + (rowb + rr) * 1024, lane, kneed[rr], d); prefix[rr] = d; }
  __syncthreads();
#pragma unroll 1
  for (int pass = 1; pass < 3; ++pass) {
    const int sh = (pass == 1) ? 10 : 0, msh = (pass == 1) ? 21 : 10;
    const u32 dmsk = (pass == 1) ? 2047u : 1023u;
#pragma unroll
    for (int j = 0; j < 16; ++j) ((uint4*)hist)[lane + 64 * j] = make_uint4(0, 0, 0, 0);
    __threadfence_block();
    for (int c0 = lane; c0 < nmax; c0 += 512) {
      u32 kk[4][8];
#pragma unroll
      for (int rr = 0; rr < 4; ++rr)
#pragma unroll
        for (int j = 0; j < 8; ++j) { const int c = c0 + 64 * j; kk[rr][j] = (c < nbase + rr) ? sr0[rr * 8192 + c] : 0u; }
#pragma unroll
      for (int rr = 0; rr < 4; ++rr)
#pragma unroll
        for (int j = 0; j < 8; ++j) {
          const int c = c0 + 64 * j;
          const u32 k = kk[rr][j];
          const bool mt = (c < nbase + rr) && ((k >> msh) == prefix[rr]);
          const u32 bin = (k >> sh) & dmsk;
          if (mt) atomicAdd(&hist[rr * 1024 + (bin >> 1)], 1u << ((bin & 1u) << 4));
        }
    }
    __threadfence_block();
#pragma unroll
    for (int rr = 0; rr < 4; ++rr) {
      u32 d;
      radix_extract(hist + rr * 1024, lane, kneed[rr], d);
      prefix[rr] = (prefix[rr] << ((pass == 1) ? 11 : 10)) | d;
    }
    __threadfence_block();
  }
  {
    int taken[4] = {0, 0, 0, 0};
    const int kend = ((t0 + rowb) | 127) + 1;
    for (int cb = 0; cb < kend; cb += 256) {
      u32 kk[4][4];
#pragma unroll
      for (int rr = 0; rr < 4; ++rr)
#pragma unroll
        for (int j = 0; j < 4; ++j) { const int c = cb + 64 * j + lane; kk[rr][j] = (c < nbase + rr) ? sr0[rr * 8192 + c] : 0u; }
#pragma unroll
      for (int rr = 0; rr < 4; ++rr) {
        const u32 T = prefix[rr];
#pragma unroll
        for (int j = 0; j < 4; ++j) {
          const int c0 = cb + 64 * j, c = c0 + lane;
          const u32 k = kk[rr][j];
          const bool gt = k > T, eq = (c < nbase + rr) && (k == T);
          const u64 eqm = __ballot(eq);
          const int rank = taken[rr] + __builtin_popcountll(eqm & ((1ull << lane) - 1ull));
          const bool sel = gt || (eq && rank < kneed[rr]);
          taken[rr] += __builtin_popcountll(eqm);
          const u64 sm = __ballot(sel);
          if (lane == 0 && c0 < kend) *(u64*)(p.dmask + (size_t)(t0 + rowb + rr) * 256 + (c0 >> 5)) = sm;
        }
      }
    }
  }
}

enum { PH_PREP = 0, PH_WIN, PH_MIX1, PH_MIX2, PH_WOUT, PH_NORM2, PH_CQ, PH_CROSS, PH_CO, PH_NORM3, PH_UP, PH_CONV, PH_DOWN, PH_COUNT };

DI void convert_matrix(const float* W, int K, int N, int Npad, u16* Wt, unsigned char* smem) {
  const int nkt = K / 64, cnt = nkt * (Npad / 128);
  for (int t = blockIdx.x; t < cnt; t += gridDim.x) convert_tile(W, K, N, Wt, t % nkt, t / nkt, (float*)smem);
}

DI void phase_prep(const Params& p, int layer, unsigned char* smem) {
  constexpr int T0 = (D_ / 64) * (DINP / 128), T1 = T0 + (D_ / 64) * (D_ / 128), T2 = T1 + (D_ / 64) * (512 / 128),
                T3 = T2 + (D_ / 64) * (1024 / 128), T4 = T3 + (512 / 64) * (D_ / 128), T5 = T4 + (D_ / 64) * (DFF2 / 128),
                T6 = T5 + (DFF / 64) * (D_ / 128);
  for (int t = lbid(); t < T6; t += gridDim.x) {
    const float* W; u16* Wt; int K, N, tt;
    if (t < T0) { W = p.w_in + (size_t)layer * D_ * DIN; Wt = p.wt_in; K = D_; N = DIN; tt = t; }
    else if (t < T1) { W = p.w_out + (size_t)layer * D_ * D_; Wt = p.wt_out; K = D_; N = D_; tt = t - T0; }
    else if (t < T2) { W = p.cross_wq + (size_t)layer * D_ * 512; Wt = p.wt_cq; K = D_; N = 512; tt = t - T1; }
    else if (t < T3) { W = p.cross_wkv + (size_t)layer * D_ * 1024; Wt = p.wt_ckv; K = D_; N = 1024; tt = t - T2; }
    else if (t < T4) { W = p.cross_wo + (size_t)layer * 512 * D_; Wt = p.wt_co; K = 512; N = D_; tt = t - T3; }
    else if (t < T5) { W = p.w_up + (size_t)layer * D_ * DFF2; Wt = p.wt_up; K = D_; N = DFF2; tt = t - T4; }
    else { W = p.w_down + (size_t)layer * DFF * D_; Wt = p.wt_down; K = DFF; N = D_; tt = t - T5; }
    const int nkt = K / 64;
    convert_tile(W, K, N, Wt, tt % nkt, tt / nkt, (float*)smem);
  }
  const float* xsrc = (layer == 0) ? p.x : p.out;
  const int wv = ltid() >> 6;
  for (int r = blockIdx.x * 4 + wv; r < S_ + MEML; r += gridDim.x * 4) {
    if (r < S_) rownorm(xsrc, p.attn_norm + layer * D_, p.hbuf, r);
    else rownorm(p.mem, p.mem_norm + layer * D_, p.mnorm, r - S_);
  }
}

DI void phase_norm(const Params& p, const float* g) {
  const int wv = ltid() >> 6;
  for (int r = blockIdx.x * 4 + wv; r < S_; r += gridDim.x * 4) rownorm(p.out, g, p.hbuf, r);
}

DI void phase_win(const Params& p, int layer, unsigned char* smem, int* ctr) {
  const int ntile = 64 * 53 + 16;
  for (int it = lbid(); it < ntile; it += gridDim.x) {
    __syncthreads();
    EpiStage es; es.gain = nullptr; es.out = p.proj; es.ldo = DIN; es.col = 0; es.vt = nullptr; es.vtS = S_; es.kind = K_RAW;
    if (it < 64 * 53) {
      const int mt = it & 63, nt = it >> 6, n0 = nt * 128;
      es.col = n0;
      if (n0 < C_MK) { es.kind = K_NR128; es.gain = p.moba_g + layer * 256; }
      else if (n0 < C_MV) { es.kind = K_NR128; es.gain = p.moba_g + layer * 256 + 128; }
      else if (n0 < C_DQ) { es.kind = K_VT; es.vt = p.vT + (size_t)((n0 - C_MV) >> 7) * 128 * S_; }
      else if (n0 < C_DK) { es.kind = K_NR64; es.gain = p.diff_g + layer * 128; }
      else if (n0 < C_DV) { es.kind = K_NR64; es.gain = p.diff_g + layer * 128 + 64; }
      else if (n0 < C_SQ) { es.kind = K_VT; es.vt = p.vT + (size_t)(6 + ((n0 - C_DV) >> 7)) * 128 * S_; }
      else if (n0 < C_SK) { es.kind = K_NR128; es.gain = p.dsa_g + layer * 256; }
      else if (n0 < C_SV) { es.kind = K_NR128; es.gain = p.dsa_g + layer * 256 + 128; }
      else if (n0 < C_IQ) { es.kind = K_VT; es.vt = p.vT + (size_t)(10 + ((n0 - C_SV) >> 7)) * 128 * S_; }
      else if (n0 < C_IK) { es.kind = K_R64; }
      else { es.kind = K_IKIW; }
      gemm_tile<0>(p, p.hbuf, D_, p.wt_in, D_, D_, mt * 128, n0, smem, es, nullptr, nullptr);
    } else {
      const int j = it - 64 * 53, mt = j & 1, nt = j >> 1;
      if (nt < 4) { es.kind = K_N128; es.gain = p.cross_g + layer * 256 + 128; es.out = p.ck; es.ldo = 512; es.col = nt * 128; }
      else { es.kind = K_VT; es.vt = p.cvT + (size_t)(nt - 4) * 128 * MEML; es.vtS = MEML; }
      gemm_tile<0>(p, p.mnorm, D_, p.wt_ckv, D_, D_, mt * 128, nt * 128, smem, es, nullptr, nullptr);
    }
  }
}

constexpr int PB_ROW = 272, PB_PART = 128 * PB_ROW, PB_SLOT = 2 * PB_PART;
DI void split_order(int s, int& qt, int& part, int& nparts) {
  if (s < 80) {
    const int g = s / 5, k = s % 5;
    if (k == 0) { qt = 31 - g; part = 0; nparts = 1; }
    else { qt = 63 - 2 * g - ((k - 1) >> 1); part = (k - 1) & 1; nparts = 2; }
  } else { qt = 15 - (s - 80); part = 0; nparts = 1; }
}
DI void st_wt(void* p, u32 lo, u32 hi) {
  __hip_atomic_store((u64*)p, (u64)lo | ((u64)hi << 32), __ATOMIC_RELAXED, __HIP_MEMORY_SCOPE_AGENT);
}
DI u64 ld_wt(const void* p) { return __hip_atomic_load((u64*)p, __ATOMIC_RELAXED, __HIP_MEMORY_SCOPE_AGENT); }
DI bool split_finish(f32x16 (&O)[4], float& m, float& l, float sc2, unsigned char* pslot, int part, int* flag, unsigned char* smem) {
  const int lane = ltid() & 63, wid = ltid() >> 6, lr = lane & 31, lh = lane >> 5;
  const int ql = 32 * wid + lr;
  unsigned char* mine = pslot + part * PB_PART + ql * PB_ROW;
#pragma unroll
  for (int b = 0; b < 4; ++b)
#pragma unroll
    for (int g = 0; g < 4; ++g)
      st_wt(mine + (32 * b + 8 * g + 4 * lh) * 2, pack2(O[b][4 * g], O[b][4 * g + 1]), pack2(O[b][4 * g + 2], O[b][4 * g + 3]));
  if (lh == 0) st_wt(mine + 256, __float_as_uint(m), __float_as_uint(l));
  asm volatile("s_waitcnt vmcnt(0)" ::: "memory");
  __syncthreads();
  if (ltid() == 0) ((volatile int*)smem)[2] = atomicAdd(flag, 1);
  __syncthreads();
  const int old = ((volatile int*)smem)[2];
  if (old == 0) return false;
  const unsigned char* oth = pslot + (part ^ 1) * PB_PART + ql * PB_ROW;
  const u64 mlw = ld_wt(oth + 256);
  const float m2 = __uint_as_float((u32)mlw), l2 = __uint_as_float((u32)(mlw >> 32));
  const float M = fmaxf(m, m2);
  const float a = __builtin_amdgcn_exp2f((m - M) * sc2), bb = __builtin_amdgcn_exp2f((m2 - M) * sc2);
#pragma unroll
  for (int b = 0; b < 4; ++b)
#pragma unroll
    for (int g = 0; g < 4; ++g) {
      const u64 w = ld_wt(oth + (32 * b + 8 * g + 4 * lh) * 2);
      const u32 wx = (u32)w, wy = (u32)(w >> 32);
      const u32 o0 = pack2(O[b][4 * g], O[b][4 * g + 1]), o1 = pack2(O[b][4 * g + 2], O[b][4 * g + 3]);
      O[b][4 * g] = a * bflo(o0) + bb * bflo(wx);
      O[b][4 * g + 1] = a * bfhi(o0) + bb * bfhi(wx);
      O[b][4 * g + 2] = a * bflo(o1) + bb * bflo(wy);
      O[b][4 * g + 3] = a * bfhi(o1) + bb * bfhi(wy);
    }
  l = a * l + bb * l2;
  m = M;
  return true;
}

DI void kbar_item(const Params& p, int idx, unsigned char* smem) {
  const int n = idx / 6, hd = idx % 6, tid = ltid(), d = tid & 127, hf = tid >> 7;
  const u16* kp = p.proj + (size_t)(n * 256 + hf * 128) * DIN + C_MK + hd * 128 + d;
  float s = 0.f;
  for (int j = 0; j < 128; ++j) s += __uint_as_float(((u32)kp[(size_t)j * DIN]) << 16);
  float* sm = (float*)smem + 16;
  if (hf) sm[d] = s;
  __syncthreads();
  if (!hf) p.kbar[(size_t)(n * 6 + hd) * 128 + d] = (s + sm[d]) * (1.0f / 256.0f);
}

DI void diff_item(const Params& p, int layer, int qt, int hh, int c, int part, int nparts, unsigned char* smem) {
  f32x16 O[4];
  float l, m;
  const int q0 = qt * 128, nk = 2 * qt + 2;
  const int lo = (nparts == 2 && part == 1) ? qt + 1 : 0, hi = (nparts == 2 && part == 0) ? qt + 1 : nk;
  const float sc2 = 0.125f * 1.4426950408889634f;
  attn_core<64, 1, DIN, DIN, S_>(p.proj + C_DQ + hh * 128 + c * 64, p.proj + C_DK + hh * 128 + c * 64, p.vT + (size_t)(6 + hh) * 128 * S_,
                   q0, lo, hi, sc2, nullptr, nullptr, smem, O, l, m);
  if (nparts == 2) {
    const int slot = (qt - 32) * 8 + hh * 2 + c;
    if (!split_finish(O, m, l, sc2, (unsigned char*)p.mixed + (size_t)slot * PB_SLOT, part, p.counters + 512 + layer * 1024 + slot, smem)) return;
  }
  const float linv = 1.0f / l;
  const int lane = ltid() & 63, wid = ltid() >> 6, lr = lane & 31, lh = lane >> 5;
  const int q = q0 + 32 * wid + lr;
  float* dst = p.dscr + ((size_t)(c * 4 + hh) * S_ + q) * 128;
#pragma unroll
  for (int b = 0; b < 4; ++b)
#pragma unroll
    for (int g = 0; g < 4; ++g)
      *(float4*)(dst + 32 * b + 8 * g + 4 * lh) =
          make_float4(O[b][4 * g] * linv, O[b][4 * g + 1] * linv, O[b][4 * g + 2] * linv, O[b][4 * g + 3] * linv);
}

DI void diff_combine_item(const Params& p, int layer, int qt, int hh) {
  const float* lf = p.diff_lam + layer * 256;
  float s1 = 0.f, s2 = 0.f;
  for (int j = 0; j < 64; ++j) { s1 += lf[j] * lf[64 + j]; s2 += lf[128 + j] * lf[192 + j]; }
  const float lam_init = (layer == 0) ? 0.2f : (0.8f - 0.6f * 0.74081822068171788f);
  const float lam = __expf(s1) - __expf(s2) + lam_init;
  const int tid = ltid(), r = tid >> 1, hf = tid & 1;
  const int q = qt * 128 + r;
  const float* o1 = p.dscr + ((size_t)(0 * 4 + hh) * S_ + q) * 128 + 64 * hf;
  const float* o2 = p.dscr + ((size_t)(1 * 4 + hh) * S_ + q) * 128 + 64 * hf;
  float a[64];
  float ss = 0.f;
#pragma unroll
  for (int j = 0; j < 16; ++j) {
    float4 u = ((const float4*)o1)[j], v = ((const float4*)o2)[j];
    a[4 * j] = u.x - lam * v.x; a[4 * j + 1] = u.y - lam * v.y; a[4 * j + 2] = u.z - lam * v.z; a[4 * j + 3] = u.w - lam * v.w;
    ss += a[4 * j] * a[4 * j] + a[4 * j + 1] * a[4 * j + 1] + a[4 * j + 2] * a[4 * j + 2] + a[4 * j + 3] * a[4 * j + 3];
  }
  ss += __shfl_xor(ss, 1);
  const float rs = rsqrtf(ss * (1.0f / 128) + 1e-6f) * (1.0f - lam_init);
  const float* g = p.diff_subln + layer * 128 + 64 * hf;
  uint4* dst = (uint4*)(p.mixed + (size_t)q * D_ + 768 + hh * 128 + 64 * hf);
#pragma unroll
  for (int j = 0; j < 8; ++j)
    dst[j] = make_uint4(pack2(a[8 * j] * rs * g[8 * j], a[8 * j + 1] * rs * g[8 * j + 1]),
                        pack2(a[8 * j + 2] * rs * g[8 * j + 2], a[8 * j + 3] * rs * g[8 * j + 3]),
                        pack2(a[8 * j + 4] * rs * g[8 * j + 4], a[8 * j + 5] * rs * g[8 * j + 5]),
                        pack2(a[8 * j + 6] * rs * g[8 * j + 6], a[8 * j + 7] * rs * g[8 * j + 7]));
}

DI void phase_mix1(const Params& p, int layer, unsigned char* smem, int* ctrA, int* ctrB) {
  if (blockIdx.x < SEL_BLOCKS) {
    for (;;) {
      const int it = next_item(ctrA, smem);
      if (it >= 512 - 16) break;
      dsa_select_item(p, 511 - it, smem);
    }
  }
  for (;;) {
    const int it = next_item(ctrB, smem);
    if (it >= 768 + 192) break;
    if (it < 768) {
      int qt, part, nparts;
      split_order(it >> 3, qt, part, nparts);
      diff_item(p, layer, qt, (it & 7) >> 1, it & 1, part, nparts, smem);
    } else kbar_item(p, it - 768, smem);
  }
}

DI void phase_mix2(const Params& p, int layer, unsigned char* smem, int* ctr) {
  const float sc2 = 0.08838834764831845f * 1.4426950408889634f;
  for (;;) {
    const int it = next_item(ctr, smem);
    if (it >= 1152 + 256) break;
    if (it < 1152) {
      int qt, part, nparts;
      const int wh = it % 12;
      split_order(it / 12, qt, part, nparts);
      const int q0 = qt * 128, nk = 2 * qt + 2;
      const int lo = (nparts == 2 && part == 1) ? qt + 1 : 0, hi = (nparts == 2 && part == 0) ? qt + 1 : nk;
      f32x16 O[4];
      float l, m;
      const int lane = ltid() & 63, wid = ltid() >> 6;
      const int q = q0 + 32 * wid + (lane & 31);
      if (wh < 6) {
        attn_core<128, 2, DIN, DIN, S_>(p.proj + C_MQ + wh * 128, p.proj + C_MK + wh * 128, p.vT + (size_t)wh * 128 * S_, q0,
                          lo, hi, sc2, nullptr, p.kbar + wh * 128, smem, O, l, m);
      } else {
        const int hd = wh - 6;
        attn_core<128, 3, DIN, DIN, S_>(p.proj + C_SQ + hd * 128, p.proj + C_SK + hd * 128, p.vT + (size_t)(10 + hd) * 128 * S_, q0,
                          lo, hi, sc2, p.dmask, nullptr, smem, O, l, m);
      }
      bool fin = true;
      if (nparts == 2) {
        const int slot = (qt - 32) * 12 + wh;
        fin = split_finish(O, m, l, sc2, (unsigned char*)p.scores + (size_t)slot * PB_SLOT, part, p.counters + 512 + layer * 1024 + 512 + slot, smem);
      }
      if (fin) write_O_bf16(O, 1.0f / l, p.mixed + (wh < 6 ? wh * 128 : 1280 + (wh - 6) * 128), D_, q);
    } else {
      const int j = it - 1152;
      diff_combine_item(p, layer, j >> 2, j & 3);
    }
  }
}

DI void phase_gemm_res(const Params& p, const u16* A, int lda, const u16* Bt, int K, const float* res, unsigned char* smem, int* ctr) {
  EpiStage es{};
  for (int it = lbid(); it < 64 * 16; it += gridDim.x) {
    __syncthreads();
    gemm_tile<1>(p, A, lda, Bt, K, K, (it & 63) * 128, (it >> 6) * 128, smem, es, res, p.out);
  }
}

DI void phase_cq(const Params& p, int layer, unsigned char* smem, int* ctr) {
  for (int it = lbid(); it < 64 * 4; it += gridDim.x) {
    __syncthreads();
    const int qt = it & 63, h = it >> 6, q0 = qt * 128;
    EpiStage es; es.kind = K_N128; es.gain = p.cross_g + layer * 256; es.out = p.cq; es.ldo = 512; es.col = h * 128; es.vt = nullptr; es.vtS = 0;
    gemm_tile<0>(p, p.hbuf, D_, p.wt_cq, D_, D_, q0, h * 128, smem, es, nullptr, nullptr);
    asm volatile("s_waitcnt vmcnt(0)" ::: "memory");
    __syncthreads();
    f32x16 O[4];
    float l, mdummy;
    attn_core<128, 0, 512, 512, MEML>(p.cq + h * 128, p.ck + h * 128, p.cvT + (size_t)h * 128 * MEML, q0, 0, 4,
                      0.08838834764831845f * 1.4426950408889634f, nullptr, nullptr, smem, O, l, mdummy);
    const int lane = ltid() & 63, wid = ltid() >> 6;
    write_O_bf16(O, 1.0f / l, p.co + h * 128, 512, q0 + 32 * wid + (lane & 31));
  }
}

DI void phase_cross(const Params& p, unsigned char* smem, int* ctr) {
  for (int it = lbid(); it < 256; it += gridDim.x) {
    __syncthreads();
    const int qt = it >> 2, h = it & 3, q0 = qt * 128;
    f32x16 O[4];
    float l;
    float mdummy;
    attn_core<128, 0, 512, 512, MEML>(p.cq + h * 128, p.ck + h * 128, p.cvT + (size_t)h * 128 * MEML, q0, 0, 4,
                      0.08838834764831845f * 1.4426950408889634f, nullptr, nullptr, smem, O, l, mdummy);
    const int lane = ltid() & 63, wid = ltid() >> 6;
    write_O_bf16(O, 1.0f / l, p.co + h * 128, 512, q0 + 32 * wid + (lane & 31));
  }
}

DI void phase_up(const Params& p, unsigned char* smem, int* ctr) {
  for (int it = lbid(); it < 64 * 86; it += gridDim.x) {
    __syncthreads();
    EpiStage es; es.kind = K_RAW; es.gain = nullptr; es.out = p.ubuf; es.ldo = DFF2; es.col = (it >> 6) * 128; es.vt = nullptr; es.vtS = 0;
    gemm_tile<0>(p, p.hbuf, D_, p.wt_up, D_, D_, (it & 63) * 128, (it >> 6) * 128, smem, es, nullptr, nullptr);
  }
}

DI uint4 ldnt16(const u16* p) { const u32x4 v = __builtin_nontemporal_load((const u32x4*)p); return make_uint4(v[0], v[1], v[2], v[3]); }
DI void unpack8(uint4 a, float (&o)[8]) {
  o[0] = bflo(a.x); o[1] = bfhi(a.x); o[2] = bflo(a.y); o[3] = bfhi(a.y); o[4] = bflo(a.z); o[5] = bfhi(a.z); o[6] = bflo(a.w); o[7] = bfhi(a.w);
}

DI void phase_conv(const Params& p, int layer, unsigned char* smem, int* ctr) {
  const float* cw = p.conv_w + (size_t)layer * 3 * DFF2;
  const float* cb = p.conv_b + (size_t)layer * DFF2;
  for (int it = lbid(); it < 512; it += gridDim.x) {
    const int t0 = it * 16;
    for (int cg8 = ltid(); cg8 < DFF / 8; cg8 += NTHR) {
      const int j0 = cg8 * 8;
      float wg[3][8], wv[3][8], bg[8], bv[8];
#pragma unroll
      for (int d = 0; d < 3; ++d)
#pragma unroll
        for (int e = 0; e < 8; ++e) { wg[d][e] = cw[d * DFF2 + j0 + e]; wv[d][e] = cw[d * DFF2 + DFF + j0 + e]; }
#pragma unroll
      for (int e = 0; e < 8; ++e) { bg[e] = cb[j0 + e]; bv[e] = cb[DFF + j0 + e]; }
      float g2[8], g1[8], v2[8], v1[8];
#pragma unroll
      for (int e = 0; e < 8; ++e) { g2[e] = 0.f; g1[e] = 0.f; v2[e] = 0.f; v1[e] = 0.f; }
      if (t0 >= 2) {
        unpack8(ldnt16(p.ubuf + (size_t)(t0 - 2) * DFF2 + j0), g2);
        unpack8(ldnt16(p.ubuf + (size_t)(t0 - 2) * DFF2 + DFF + j0), v2);
        unpack8(ldnt16(p.ubuf + (size_t)(t0 - 1) * DFF2 + j0), g1);
        unpack8(ldnt16(p.ubuf + (size_t)(t0 - 1) * DFF2 + DFF + j0), v1);
      }
#pragma unroll 8
      for (int r = 0; r < 16; ++r) {
        const int t = t0 + r;
        float g0[8], v0[8], o[8];
        unpack8(ldnt16(p.ubuf + (size_t)t * DFF2 + j0), g0);
        unpack8(ldnt16(p.ubuf + (size_t)t * DFF2 + DFF + j0), v0);
#pragma unroll
        for (int e = 0; e < 8; ++e) {
          const float gg = wg[0][e] * g2[e] + wg[1][e] * g1[e] + wg[2][e] * g0[e] + bg[e];
          const float vv = wv[0][e] * v2[e] + wv[1][e] * v1[e] + wv[2][e] * v0[e] + bv[e];
          o[e] = gg / (1.0f + __expf(-gg)) * vv;
          g2[e] = g1[e]; g1[e] = g0[e]; v2[e] = v1[e]; v1[e] = v0[e];
        }
        *(uint4*)(p.act + (size_t)t * DFF + j0) = make_uint4(pack2(o[0], o[1]), pack2(o[2], o[3]), pack2(o[4], o[5]), pack2(o[6], o[7]));
      }
    }
  }
}

template <int PH>
DI void run_phase(const Params& p, int layer, unsigned char* smem, int cofs = 0) {
  int* ctr = p.counters + (layer * 16 + PH) + cofs;
  if (PH == PH_PREP) phase_prep(p, layer, smem);
  if (PH == PH_WIN) phase_win(p, layer, smem, ctr);
  if (PH == PH_MIX1) phase_mix1(p, layer, smem, ctr, p.counters + (layer * 16 + 14) + cofs);
  if (PH == PH_MIX2) phase_mix2(p, layer, smem, ctr);
  if (PH == PH_WOUT) phase_gemm_res(p, p.mixed, D_, p.wt_out, D_, (layer == 0) ? p.x : p.out, smem, ctr);
  if (PH == PH_NORM2) phase_norm(p, p.cross_norm + layer * D_);
  if (PH == PH_CQ) phase_cq(p, layer, smem, ctr);
  if (PH == PH_CROSS) phase_cross(p, smem, ctr);
  if (PH == PH_CO) phase_gemm_res(p, p.co, 512, p.wt_co, 512, p.out, smem, ctr);
  if (PH == PH_NORM3) phase_norm(p, p.ffn_norm + layer * D_);
  if (PH == PH_UP) phase_up(p, smem, ctr);
  if (PH == PH_CONV) phase_conv(p, layer, smem, ctr);
  if (PH == PH_DOWN) phase_gemm_res(p, p.act, DFF, p.wt_down, DFF, p.out, smem, ctr);
}


#define XB_TMO      128
#define XB_XCNT(j)  (256  + 64 * (j))
#define XB_XSUB(j)  (1280 + 64 * (j))
#define XB_XGEN(j)  (2304 + 64 * (j))
#define XB_TOP      3328
#define XB_TOPGEN   3392
#define XCD_BAR_WORDS 3456
#define XB_SPIN_CAP (1u << 20)
DI unsigned xb_ld(unsigned* p) { return __hip_atomic_load(p, __ATOMIC_RELAXED, __HIP_MEMORY_SCOPE_AGENT); }
DI unsigned xb_add(unsigned* p, unsigned v) { return __hip_atomic_fetch_add(p, v, __ATOMIC_RELAXED, __HIP_MEMORY_SCOPE_AGENT); }
DI unsigned xb_xcc_id() { return (unsigned)__builtin_amdgcn_s_getreg((3 << 11) | 20) & 0xFu; }
#define XB_SPIN(cond, bar) do { unsigned _sp = 0; while (cond) { __builtin_amdgcn_s_sleep(1); \
    if ((++_sp & 255u) == 0u) { if (xb_ld(&(bar)[XB_TMO])) break; if (_sp > XB_SPIN_CAP) { atomicAdd(&(bar)[XB_TMO], 1u); break; } } } } while (0)

DI void xb_init(unsigned* bar) {
  const int t = __builtin_amdgcn_workitem_id_x();
  if (t == 0) {
    const unsigned x = xb_xcc_id();
    (void)xb_add(&bar[XB_XCNT(x)], 1u);
    const unsigned G = gridDim.x;
    unsigned sum, cnt, mine, sp = 0u;
    for (;;) {
      sum = 0u; cnt = 0u; mine = 0u;
#pragma unroll
      for (unsigned j = 0; j < 16; ++j) { const unsigned c = xb_ld(&bar[XB_XCNT(j)]); sum += c; cnt += (c > 0u) ? 1u : 0u; mine = (j == x) ? c : mine; }
      if (sum == G) break;
      __builtin_amdgcn_s_sleep(1);
      if ((++sp & 255u) == 0u) { if (xb_ld(&bar[XB_TMO])) break; if (sp > XB_SPIN_CAP) { atomicAdd(&bar[XB_TMO], 1u); break; } }
    }
    const int bid = lbid();
    bar[XCD_BAR_WORDS + 2 * bid] = mine > 0u ? mine : 1u;
    bar[XCD_BAR_WORDS + 2 * bid + 1] = cnt > 0u ? cnt : 1u;
  }
  __syncthreads();
}

DI void xcd_barrier(unsigned* bar) {
  asm volatile("s_waitcnt vmcnt(0)" ::: "memory");
  __syncthreads();
  if (__builtin_amdgcn_workitem_id_x() == 0) {
    __builtin_amdgcn_s_waitcnt(0);
    const unsigned x = xb_xcc_id();
    const int bid = lbid();
    const unsigned nloc = bar[XCD_BAR_WORDS + 2 * bid], nx = bar[XCD_BAR_WORDS + 2 * bid + 1];
    const unsigned old = xb_add(&bar[XB_XSUB(x)], 1u);
    const unsigned gen = old / nloc;
    if (old + 1u == (gen + 1u) * nloc) {
      __builtin_amdgcn_fence(__ATOMIC_RELEASE, "agent");
      asm volatile("s_waitcnt vmcnt(0)" ::: "memory");
      const unsigned og = xb_add(&bar[XB_TOP], 1u);
      const unsigned tg = og / nx;
      if (og + 1u == (tg + 1u) * nx) xb_add(&bar[XB_TOPGEN], 1u);
      else XB_SPIN(xb_ld(&bar[XB_TOPGEN]) == tg, bar);
      __builtin_amdgcn_fence(__ATOMIC_ACQUIRE, "agent");
      xb_add(&bar[XB_XGEN(x)], 1u);
      asm volatile("s_waitcnt vmcnt(0)" ::: "memory");
    } else {
      XB_SPIN(xb_ld(&bar[XB_XGEN(x)]) == gen, bar);
      __builtin_amdgcn_fence(__ATOMIC_ACQUIRE, "agent");
      asm volatile("s_waitcnt vmcnt(0)" ::: "memory");
    }
  }
  __syncthreads();
}

typedef const Params __attribute__((address_space(4)))* CP4;
DI const Params& launder() {
  CP4 q = (CP4)__builtin_amdgcn_kernarg_segment_ptr();
  asm volatile("" : "+s"(q));
  return *(const Params*)q;
}

#if MULTI
template <int PH>
__global__ void __launch_bounds__(NTHR, 2) phase_kernel(Params p, int layer) {
  __shared__ __attribute__((aligned(16))) unsigned char smem[65536];
  run_phase<PH>(p, layer, smem);
}
#else
__global__ void __launch_bounds__(NTHR, 2) mega_kernel(Params p) {
  __shared__ __attribute__((aligned(16))) unsigned char smem[65536];
  cg::grid_group grid = cg::this_grid();
  xb_init(launder().bar);
#define SEAM() xcd_barrier(launder().bar)
#pragma unroll 1
  for (int layer = 0; layer < 2; ++layer) {
    run_phase<PH_PREP>(launder(), layer, smem);
    SEAM();
    if (launder().counters == nullptr) grid.sync();
    run_phase<PH_WIN>(launder(), layer, smem); SEAM();
    run_phase<PH_MIX1>(launder(), layer, smem); SEAM();
    run_phase<PH_MIX2>(launder(), layer, smem); SEAM();
    run_phase<PH_WOUT>(launder(), layer, smem); SEAM();
    run_phase<PH_NORM2>(launder(), layer, smem); SEAM();
    run_phase<PH_CQ>(launder(), layer, smem); SEAM();
    run_phase<PH_CO>(launder(), layer, smem); SEAM();
    run_phase<PH_NORM3>(launder(), layer, smem); SEAM();
    run_phase<PH_UP>(launder(), layer, smem); SEAM();
    run_phase<PH_CONV>(launder(), layer, smem); SEAM();
    run_phase<PH_DOWN>(launder(), layer, smem);
    if (layer == 0) SEAM();
  }
}
#endif

static size_t alignup(size_t v) { return (v + 255) & ~(size_t)255; }

extern "C" void kernel_launch(void* const* d_in, const int* in_sizes, int n_in, void* d_out, int out_size, void* d_ws, size_t ws_size,
                              hipStream_t stream) {
  Params p;
  memset(&p, 0, sizeof(p));
  p.x = (const float*)d_in[0]; p.mem = (const float*)d_in[1]; p.pos = (const int*)d_in[2];
  p.attn_norm = (const float*)d_in[3]; p.w_in = (const float*)d_in[4]; p.moba_g = (const float*)d_in[5];
  p.diff_g = (const float*)d_in[6]; p.diff_lam = (const float*)d_in[7]; p.diff_subln = (const float*)d_in[8];
  p.dsa_g = (const float*)d_in[9]; p.w_out = (const float*)d_in[10]; p.cross_norm = (const float*)d_in[11];
  p.mem_norm = (const float*)d_in[12]; p.cross_wq = (const float*)d_in[13]; p.cross_wkv = (const float*)d_in[14];
  p.cross_g = (const float*)d_in[15]; p.cross_wo = (const float*)d_in[16]; p.ffn_norm = (const float*)d_in[17];
  p.w_up = (const float*)d_in[18]; p.conv_w = (const float*)d_in[19]; p.conv_b = (const float*)d_in[20];
  p.w_down = (const float*)d_in[21];
  p.out = (float*)d_out;
  unsigned char* w = (unsigned char*)d_ws;
  size_t off = 0;
  auto take = [&](size_t bytes) { unsigned char* r = w + off; off += alignup(bytes); return r; };
  p.counters = (int*)take(10240);
  p.bar = (unsigned*)take((size_t)(XCD_BAR_WORDS + 2048) * 4);
  p.wt_in = (u16*)take((size_t)DINP * D_ * 2);
  p.wt_out = (u16*)take((size_t)D_ * D_ * 2);
  p.wt_cq = (u16*)take((size_t)512 * D_ * 2);
  p.wt_ckv = (u16*)take((size_t)1024 * D_ * 2);
  p.wt_co = (u16*)take((size_t)D_ * 512 * 2);
  p.wt_up = (u16*)take((size_t)DFF2 * D_ * 2);
  p.wt_down = (u16*)take((size_t)D_ * DFF * 2);
  p.ck = (u16*)take((size_t)MEML * 512 * 2);
  p.cvT = (u16*)take((size_t)4 * 128 * MEML * 2);
  p.mnorm = (u16*)take((size_t)MEML * D_ * 2);
  p.kbar = (float*)take((size_t)32 * 768 * 4);
  p.iw = (float*)take((size_t)S_ * 8 * 4);
  p.cq = (u16*)take((size_t)S_ * 512 * 2);
  p.co = (u16*)take((size_t)S_ * 512 * 2);
  const size_t ubase = off;
  p.proj = (u16*)take((size_t)S_ * DIN * 2);
  p.vT = (u16*)take((size_t)16 * 128 * S_ * 2);
  p.mixed = (u16*)take((size_t)S_ * D_ * 2);
  p.dmask = (u32*)take((size_t)S_ * 256 * 4);
  p.dscr = (float*)take((size_t)8 * S_ * 128 * 4);
  p.scores = (u32*)take((size_t)SEL_BLOCKS * 16 * 8192 * 4);
  p.hbuf = (u16*)p.scores;
  const size_t total = off;
  p.ubuf = (u16*)(w + ubase);
  p.act = (u16*)(w + ubase + alignup((size_t)S_ * DFF2 * 2));
  const size_t ubuf_end = ubase + alignup((size_t)S_ * DFF2 * 2);
  const size_t ffn_end = ubuf_end + alignup((size_t)S_ * DFF * 2);
  if ((size_t)((unsigned char*)p.hbuf - w) < ubuf_end || ffn_end > total || total > ws_size) {
    fprintf(stderr, "workspace layout problem: total %zu ws %zu\n", total, ws_size);
    return;
  }
  for (int i = 0; i < 64; ++i) p.inv128[i] = (float)pow(10000.0, -(double)(2 * i) / 128.0);
  for (int i = 0; i < 32; ++i) p.inv64[i] = (float)pow(10000.0, -(double)(2 * i) / 64.0);

  (void)hipMemsetAsync(p.counters, 0, 10240 + (size_t)XCD_BAR_WORDS * 4, stream);
#if MULTI
  const int grid = 512;
  for (int layer = 0; layer < 2; ++layer) {
    phase_kernel<PH_PREP><<<grid, NTHR, 0, stream>>>(p, layer);
    phase_kernel<PH_WIN><<<grid, NTHR, 0, stream>>>(p, layer);
    phase_kernel<PH_MIX1><<<grid, NTHR, 0, stream>>>(p, layer);
    phase_kernel<PH_MIX2><<<grid, NTHR, 0, stream>>>(p, layer);
    phase_kernel<PH_WOUT><<<grid, NTHR, 0, stream>>>(p, layer);
    phase_kernel<PH_NORM2><<<grid, NTHR, 0, stream>>>(p, layer);
    phase_kernel<PH_CQ><<<grid, NTHR, 0, stream>>>(p, layer);
    phase_kernel<PH_CROSS><<<grid, NTHR, 0, stream>>>(p, layer);
    phase_kernel<PH_CO><<<grid, NTHR, 0, stream>>>(p, layer);
    phase_kernel<PH_NORM3><<<grid, NTHR, 0, stream>>>(p, layer);
    phase_kernel<PH_UP><<<grid, NTHR, 0, stream>>>(p, layer);
    phase_kernel<PH_CONV><<<grid, NTHR, 0, stream>>>(p, layer);
    phase_kernel<PH_DOWN><<<grid, NTHR, 0, stream>>>(p, layer);
  }
#else
  static int grid_blocks = 0;
  if (!grid_blocks) {
    int dev = 0, cus = 0, per_cu = 0;
    hipGetDevice(&dev);
    hipDeviceGetAttribute(&cus, hipDeviceAttributeMultiprocessorCount, dev);
    hipOccupancyMaxActiveBlocksPerMultiprocessor(&per_cu, mega_kernel, NTHR, 0);
    if (per_cu > 2) per_cu = 2;
    grid_blocks = cus * per_cu;
  }
  void* args[] = {&p};
  hipError_t e = hipLaunchCooperativeKernel((void*)mega_kernel, dim3(grid_blocks), dim3(NTHR), args, 0, stream);
  if (e != hipSuccess) fprintf(stderr, "cooperative launch failed: %s (grid %d)\n", hipGetErrorString(e), grid_blocks);
#endif
}
```

```cpp
#include <hip/hip_runtime.h>
#include <hip/hip_cooperative_groups.h>
#include <stdint.h>
#include <math.h>
#include <stdio.h>
#include <string.h>
namespace cg = cooperative_groups;

#ifndef MULTI
#define MULTI 0
#endif

typedef unsigned short u16;
typedef unsigned int u32;
typedef unsigned long long u64;
using bf16x8 = __attribute__((ext_vector_type(8))) short;
using s16x4 = __attribute__((ext_vector_type(4))) short;
using f32x16 = __attribute__((ext_vector_type(16))) float;
using f32x4 = __attribute__((ext_vector_type(4))) float;
using u32x4 = __attribute__((ext_vector_type(4))) unsigned;
using u32x2 = __attribute__((ext_vector_type(2))) unsigned;
typedef __bf16 bf2_t __attribute__((ext_vector_type(2)));
typedef float f2_t __attribute__((ext_vector_type(2)));
#define DI __device__ __forceinline__
#define NEG_INF (-__builtin_inff())

constexpr int S_ = 8192, D_ = 2048, DIN = 6728, DINP = 6784, DFF = 5504, DFF2 = 11008, MEML = 256;
constexpr int C_MQ = 0, C_MK = 768, C_MV = 1536, C_DQ = 2304, C_DK = 2816, C_DV = 3328, C_SQ = 3840, C_SK = 4608, C_SV = 5376,
              C_IQ = 6144, C_IK = 6656, C_IW = 6720;
constexpr int NTHR = 256;
constexpr int SEL_BLOCKS = 256;

struct Params {
  const float *x, *mem; const int* pos;
  const float *attn_norm, *w_in, *moba_g, *diff_g, *diff_lam, *diff_subln, *dsa_g, *w_out, *cross_norm, *mem_norm, *cross_wq,
      *cross_wkv, *cross_g, *cross_wo, *ffn_norm, *w_up, *conv_w, *conv_b, *w_down;
  float* out;
  u16 *wt_in, *wt_out, *wt_cq, *wt_ckv, *wt_co, *wt_up, *wt_down;
  u16 *hbuf, *proj, *vT, *mixed, *cq, *co, *ck, *cvT, *mnorm, *ubuf, *act;
  u32 *dmask, *scores; float *kbar, *iw, *dscr; int* counters; unsigned* bar;
  float inv128[64]; float inv64[32];
};

DI u32 pack2(float a, float b) { f2_t v = {a, b}; return __builtin_bit_cast(u32, __builtin_convertvector(v, bf2_t)); }
DI float bflo(u32 w) { return __uint_as_float(w << 16); }
DI float bfhi(u32 w) { return __uint_as_float(w & 0xffff0000u); }
DI int crow(int i, int h) { return (i & 3) + 8 * (i >> 2) + 4 * h; }
DI f32x16 mfma32(bf16x8 a, bf16x8 b, f32x16 c) { return __builtin_amdgcn_mfma_f32_32x32x16_bf16(a, b, c, 0, 0, 0); }
DI f32x4 mfma16(bf16x8 a, bf16x8 b, f32x4 c) { return __builtin_amdgcn_mfma_f32_16x16x32_bf16(a, b, c, 0, 0, 0); }
DI int ltid() { int t = __builtin_amdgcn_workitem_id_x(); asm volatile("" : "+v"(t)); return t; }
DI int lbid() { int b = __builtin_amdgcn_workgroup_id_x(); asm volatile("" : "+s"(b)); return b; }
DI void dma16(const void* g, void* l) { __builtin_amdgcn_global_load_lds((const unsigned*)g, (unsigned*)l, 16, 0, 0); }
DI float wave_sum(float v) {
#pragma unroll
  for (int o = 32; o >= 1; o >>= 1) v += __shfl_xor(v, o);
  return v;
}

DI int next_item(int* counter, unsigned char* smem) {
  __syncthreads();
  if (ltid() == 0) { ((int*)smem)[0] = atomicAdd(counter, 1); ((u32*)smem)[1] = 0u; }
  __syncthreads();
  const int it = ((volatile int*)smem)[0];
  __syncthreads();
  return it;
}

DI void convert_tile(const float* __restrict__ W, int K, int N, u16* __restrict__ Wt, int kt, int nt, float* tl) {
  const int tid = ltid(), ty = tid >> 5, tx = tid & 31;
  const int k0 = kt * 64, n0 = nt * 128;
  float4 v[8];
#pragma unroll
  for (int i = 0; i < 8; ++i) {
    const int k = k0 + ty + 8 * i, n = n0 + 4 * tx;
    v[i] = make_float4(0.f, 0.f, 0.f, 0.f);
    if (n < N) v[i] = *(const float4*)(W + (size_t)k * N + n);
  }
#pragma unroll
  for (int i = 0; i < 8; ++i) {
    float* d = tl + (ty + 8 * i) * 129 + 4 * tx;
    d[0] = v[i].x; d[1] = v[i].y; d[2] = v[i].z; d[3] = v[i].w;
  }
  __syncthreads();
  {
    const int n = tid >> 1, kc = tid & 1;
    u32 w[16];
#pragma unroll
    for (int j = 0; j < 16; ++j) w[j] = pack2(tl[(kc * 32 + 2 * j) * 129 + n], tl[(kc * 32 + 2 * j + 1) * 129 + n]);
    uint4* dst = (uint4*)(Wt + (size_t)(n0 + n) * K + k0 + kc * 32);
#pragma unroll
    for (int j = 0; j < 4; ++j) dst[j] = make_uint4(w[4 * j], w[4 * j + 1], w[4 * j + 2], w[4 * j + 3]);
  }
  __syncthreads();
}

DI void rownorm(const float* __restrict__ x, const float* __restrict__ g, u16* __restrict__ out, int row) {
  const int lane = ltid() & 63;
  const float4* xr = (const float4*)(x + (size_t)row * D_);
  float4 v[8];
  float ss = 0.f;
#pragma unroll
  for (int i = 0; i < 8; ++i) {
    v[i] = xr[lane + 64 * i];
    ss += v[i].x * v[i].x + v[i].y * v[i].y + v[i].z * v[i].z + v[i].w * v[i].w;
  }
  ss = wave_sum(ss);
  const float rs = rsqrtf(ss * (1.0f / D_) + 1e-6f);
  uint2* o = (uint2*)(out + (size_t)row * D_);
#pragma unroll
  for (int i = 0; i < 8; ++i) {
    float4 gg = ((const float4*)g)[lane + 64 * i];
    o[lane + 64 * i] = make_uint2(pack2(v[i].x * rs * gg.x, v[i].y * rs * gg.y), pack2(v[i].z * rs * gg.z, v[i].w * rs * gg.w));
  }
}

enum { K_NR128 = 0, K_NR64, K_R64, K_VT, K_IKIW, K_N128, K_RAW };
struct EpiStage {
  int kind; const float* gain; u16* out; int ldo; int col; u16* vt; int vtS;
};

DI void rope_cs(float posf, float inv, float& c, float& s) {
  double rev = (double)posf * (double)inv * 0.15915494309189535;
  rev = rev - floor(rev);
  float fr = (float)rev;
  s = __builtin_amdgcn_sinf(fr);
  c = __builtin_amdgcn_cosf(fr);
}

DI void epi_rows(const Params& p, const float* cs, const EpiStage& es, int mrow0) {
  const int tid = ltid();
  if (es.kind == K_VT) {
    const int c = tid >> 1, rh = tid & 1;
    u32 w[16];
#pragma unroll
    for (int j = 0; j < 16; ++j) w[j] = pack2(cs[(32 * rh + 2 * j) * 132 + c], cs[(32 * rh + 2 * j + 1) * 132 + c]);
    uint4* dst = (uint4*)(es.vt + (size_t)c * es.vtS + mrow0 + 32 * rh);
    dst[0] = make_uint4(w[0], w[1], w[4], w[5]);
    dst[1] = make_uint4(w[2], w[3], w[6], w[7]);
    dst[2] = make_uint4(w[8], w[9], w[12], w[13]);
    dst[3] = make_uint4(w[10], w[11], w[14], w[15]);
    return;
  }
  const int r = tid >> 2, qd = tid & 3;
  const int m = mrow0 + r;
  const float* cr = cs + r * 132;
  if (es.kind == K_RAW) {
    u32 w[16];
#pragma unroll
    for (int j = 0; j < 8; ++j) {
      float4 v = *(const float4*)(cr + 32 * qd + 4 * j);
      w[2 * j] = pack2(v.x, v.y); w[2 * j + 1] = pack2(v.z, v.w);
    }
    uint4* dst = (uint4*)(es.out + (size_t)m * es.ldo + es.col + 32 * qd);
#pragma unroll
    for (int j = 0; j < 4; ++j) dst[j] = make_uint4(w[4 * j], w[4 * j + 1], w[4 * j + 2], w[4 * j + 3]);
    return;
  }
  const bool d64 = !(es.kind == K_NR128 || es.kind == K_N128);
  const int hd = d64 ? (qd >> 1) : 0, sub = d64 ? (qd & 1) : qd, half = d64 ? 32 : 64;
  const int cl = hd * 64 + sub * 16, ch = cl + half;
  float lo[16], hi[16];
#pragma unroll
  for (int j = 0; j < 4; ++j) {
    float4 a = *(const float4*)(cr + cl + 4 * j), b = *(const float4*)(cr + ch + 4 * j);
    lo[4 * j] = a.x; lo[4 * j + 1] = a.y; lo[4 * j + 2] = a.z; lo[4 * j + 3] = a.w;
    hi[4 * j] = b.x; hi[4 * j + 1] = b.y; hi[4 * j + 2] = b.z; hi[4 * j + 3] = b.w;
  }
  float ss = 0.f;
#pragma unroll
  for (int j = 0; j < 16; ++j) ss += lo[j] * lo[j] + hi[j] * hi[j];
  ss += __shfl_xor(ss, 1);
  const float ss2 = ss + __shfl_xor(ss, 2);
  if (!d64) ss = ss2;
  const bool donorm = (es.kind == K_NR128 || es.kind == K_NR64 || es.kind == K_N128);
  if (donorm) {
    const float rs = rsqrtf(ss * (d64 ? (1.0f / 64) : (1.0f / 128)) + 1e-6f);
#pragma unroll
    for (int j = 0; j < 16; ++j) {
      lo[j] *= rs * es.gain[sub * 16 + j];
      hi[j] *= rs * es.gain[sub * 16 + j + half];
    }
  }
  if (es.kind != K_N128) {
    const float posf = (float)p.pos[m];
#pragma unroll
    for (int j = 0; j < 16; ++j) {
      const int i = sub * 16 + j;
      const float inv = d64 ? p.inv64[i] : p.inv128[i];
      float c, s;
      rope_cs(posf, inv, c, s);
      const float a = lo[j], b = hi[j];
      lo[j] = a * c - b * s;
      hi[j] = b * c + a * s;
    }
  }
  if (es.kind == K_IKIW) {
    if (qd == 2) {
      float4 a = *(const float4*)(cr + 64), b = *(const float4*)(cr + 68);
      float4* d = (float4*)(p.iw + (size_t)m * 8);
      d[0] = a; d[1] = b;
    }
    if (qd >= 2) return;
  }
  u16* orow = es.out + (size_t)m * es.ldo + es.col;
  uint4* d0 = (uint4*)(orow + cl);
  uint4* d1 = (uint4*)(orow + ch);
  d0[0] = make_uint4(pack2(lo[0], lo[1]), pack2(lo[2], lo[3]), pack2(lo[4], lo[5]), pack2(lo[6], lo[7]));
  d0[1] = make_uint4(pack2(lo[8], lo[9]), pack2(lo[10], lo[11]), pack2(lo[12], lo[13]), pack2(lo[14], lo[15]));
  d1[0] = make_uint4(pack2(hi[0], hi[1]), pack2(hi[2], hi[3]), pack2(hi[4], hi[5]), pack2(hi[6], hi[7]));
  d1[1] = make_uint4(pack2(hi[8], hi[9]), pack2(hi[10], hi[11]), pack2(hi[12], hi[13]), pack2(hi[14], hi[15]));
}

template <int EPI>
DI void gemm_tile(const Params& p, const u16* __restrict__ A, int lda, const u16* __restrict__ Bt, int ldb, int K, int m0, int n0,
                  unsigned char* smem, const EpiStage& es, const float* res, float* outp) {
  const int tid = ltid(), lane = tid & 63, wid = tid >> 6, wm = wid >> 1, wn = wid & 1;
  const int lr = lane & 31, lh = lane >> 5;
  f32x16 acc[2][2];
#pragma unroll
  for (int a = 0; a < 2; ++a)
#pragma unroll
    for (int b = 0; b < 2; ++b)
#pragma unroll
      for (int i = 0; i < 16; ++i) acc[a][b][i] = 0.f;

  const u16* Ag = A + (size_t)(m0 + (tid >> 3)) * lda + (((tid & 7) ^ ((tid >> 4) & 7)) << 3);
  const u16* Bg = Bt + (size_t)(n0 + (tid >> 3)) * ldb + (((tid & 7) ^ ((tid >> 4) & 7)) << 3);
  const int wofs = tid * 16;
  const int sw = (lr >> 1) & 7;
  const int aofs = (wm * 64 + lr) * 128, bofs = 16384 + (wn * 64 + lr) * 128;
  const int nk = K >> 6;
#define G_DMA(BUF, KT) _Pragma("unroll") for (int i = 0; i < 4; ++i) { \
    dma16(Ag + (size_t)(32 * i) * lda + (KT) * 64, smem + (BUF) * 32768 + wofs + i * 4096); \
    dma16(Bg + (size_t)(32 * i) * ldb + (KT) * 64, smem + (BUF) * 32768 + 16384 + wofs + i * 4096); }
#define G_LANDED() asm volatile("s_waitcnt vmcnt(0)" ::: "memory")
#define G_COMPUTE(BUF, DMA_STMT) { const unsigned char* sb = smem + (BUF) * 32768; \
    bf16x8 fa0[4], fa1[4], fb0[4], fb1[4]; \
    _Pragma("unroll") for (int ks = 0; ks < 4; ++ks) { \
      const int co = ((2 * ks + lh) ^ sw) << 4; \
      fa0[ks] = *(const bf16x8*)(sb + aofs + co); \
      fb0[ks] = *(const bf16x8*)(sb + bofs + co); \
      fa1[ks] = *(const bf16x8*)(sb + aofs + 4096 + co); \
      fb1[ks] = *(const bf16x8*)(sb + bofs + 4096 + co); } \
    __builtin_amdgcn_sched_barrier(0); \
    DMA_STMT; \
    __builtin_amdgcn_sched_barrier(0); \
    _Pragma("unroll") for (int ks = 0; ks < 4; ++ks) { \
      acc[0][0] = mfma32(fa0[ks], fb0[ks], acc[0][0]); \
      acc[0][1] = mfma32(fa0[ks], fb1[ks], acc[0][1]); \
      acc[1][0] = mfma32(fa1[ks], fb0[ks], acc[1][0]); \
      acc[1][1] = mfma32(fa1[ks], fb1[ks], acc[1][1]); } \
    __builtin_amdgcn_sched_barrier(0); }
  G_DMA(0, 0);
  G_LANDED();
  __syncthreads();
  for (int kt = 0; kt < nk; kt += 2) {
    G_COMPUTE(0, G_DMA(1, kt + 1));
    G_LANDED();
    __syncthreads();
    const int kl = (kt + 2 < nk) ? kt + 2 : nk - 1;
    G_COMPUTE(1, G_DMA(0, kl));
    G_LANDED();
    __syncthreads();
  }
#undef G_DMA
#undef G_LANDED
#undef G_COMPUTE
  if (EPI == 1) {
#pragma unroll
    for (int mb = 0; mb < 2; ++mb)
#pragma unroll
      for (int nb = 0; nb < 2; ++nb)
#pragma unroll
        for (int i = 0; i < 16; ++i) {
          const size_t idx = (size_t)(m0 + wm * 64 + mb * 32 + crow(i, lh)) * D_ + n0 + wn * 64 + nb * 32 + lr;
          outp[idx] = res[idx] + acc[mb][nb][i];
        }
  } else {
    float* cs = (float*)smem;
#pragma unroll
    for (int ps = 0; ps < 2; ++ps) {
      if (wm == ps) {
#pragma unroll
        for (int mb = 0; mb < 2; ++mb)
#pragma unroll
          for (int nb = 0; nb < 2; ++nb)
#pragma unroll
            for (int i = 0; i < 16; ++i) cs[(mb * 32 + crow(i, lh)) * 132 + wn * 64 + nb * 32 + lr] = acc[mb][nb][i];
      }
      __syncthreads();
      epi_rows(p, cs, es, m0 + 64 * ps);
      __syncthreads();
    }
  }
}

template <int DQK, int MODE, int ldq, int ldk, int ldv>
DI void attn_core(const u16* __restrict__ Q, const u16* __restrict__ Kp, const u16* __restrict__ Vt, int q0,
                  int kt_lo, int nkt, float sc2, const u32* __restrict__ dmask, const float* __restrict__ kbar_h, unsigned char* smem,
                  f32x16 (&O)[4], float& l_out, float& m_out) {
  constexpr int NKS = DQK / 16, RB = DQK * 2, CPR = RB / 16, KCH = 64 * CPR / NTHR;
  const int tid = ltid(), lane = tid & 63, wid = tid >> 6, lr = lane & 31, lh = lane >> 5;
  const int qw0 = q0 + 32 * wid, q = qw0 + lr;
  const int cur = q0 >> 8;
  bf16x8 qf[NKS];
  if (MODE != 2) {
#pragma unroll
    for (int ks = 0; ks < NKS; ++ks) qf[ks] = *(const bf16x8*)(Q + (size_t)q * ldq + ks * 16 + lh * 8);
  }
  float m = -1e30f, l = 0.f;
  u32 selw = 0, un = 0xffffffffu;
  if (MODE == 2) {
    f32x16 G;
#pragma unroll
    for (int i = 0; i < 16; ++i) G[i] = 0.f;
    bf16x8 gq[8];
#pragma unroll
    for (int ks = 0; ks < 8; ++ks) gq[ks] = *(const bf16x8*)(Q + (size_t)q * ldq + ks * 16 + lh * 8);
#pragma unroll
    for (int ks = 0; ks < 8; ++ks) {
      const float* kp = kbar_h + (size_t)lr * 768 + ks * 16 + lh * 8;
      float4 a = *(const float4*)kp, b = *(const float4*)(kp + 4);
      u32 h0 = pack2(a.x, a.y), h1 = pack2(a.z, a.w), h2 = pack2(b.x, b.y), h3 = pack2(b.z, b.w);
      u32 l0 = pack2(a.x - bflo(h0), a.y - bfhi(h0)), l1 = pack2(a.z - bflo(h1), a.w - bfhi(h1));
      u32 l2 = pack2(b.x - bflo(h2), b.y - bfhi(h2)), l3 = pack2(b.z - bflo(h3), b.w - bfhi(h3));
      u32x4 hv = {h0, h1, h2, h3}, lv = {l0, l1, l2, l3};
      G = mfma32(__builtin_bit_cast(bf16x8, hv), gq[ks], G);
      G = mfma32(__builtin_bit_cast(bf16x8, lv), gq[ks], G);
      if ((ks & 1) == 1) __builtin_amdgcn_sched_barrier(0);
    }
    float b0 = NEG_INF, b1 = NEG_INF, b2 = NEG_INF;
    int i0 = 0, i1 = 0, i2 = 0;
#pragma unroll
    for (int ig = 0; ig < 4; ++ig) {
#pragma unroll
      for (int hh = 0; hh < 2; ++hh) {
#pragma unroll
        for (int j = 0; j < 4; ++j) {
          const int i = 4 * ig + j;
          const float o = __shfl_xor(G[i], 32);
          const int n = 8 * ig + 4 * hh + j;
          float v = (hh == lh) ? G[i] : o;
          v = (n < cur) ? v : NEG_INF;
          const bool g0 = v > b0, g1 = v > b1, g2 = v > b2;
          b2 = g1 ? b1 : (g2 ? v : b2); i2 = g1 ? i1 : (g2 ? n : i2);
          b1 = g0 ? b0 : (g1 ? v : b1); i1 = g0 ? i0 : (g1 ? n : i1);
          b0 = g0 ? v : b0;             i0 = g0 ? n : i0;
        }
      }
    }
    if (b0 > NEG_INF) selw |= 1u << i0;
    if (b1 > NEG_INF) selw |= 1u << i1;
    if (b2 > NEG_INF) selw |= 1u << i2;
    atomicOr(((u32*)smem) + 1, selw);
    __syncthreads();
    un = ((volatile u32*)smem)[1];
    __syncthreads();
    {
      const u16* Q2 = Q + (size_t)q * ldq + lh * 8;
      asm volatile("" : "+v"(Q2));
#pragma unroll
      for (int ks = 0; ks < NKS; ++ks) qf[ks] = *(const bf16x8*)(Q2 + ks * 16);
    }
  }

#pragma unroll
  for (int b = 0; b < 4; ++b)
#pragma unroll
    for (int i = 0; i < 16; ++i) O[b][i] = 0.f;
  const int swzK = (DQK == 128) ? (lr & 15) : ((lr >> 1) & 7);
  const int vsw = (lr >> 1) & 7;
  constexpr int RPI = NTHR / CPR;
  const int kr0 = tid / CPR, kch = tid % CPR;
  const int kszw = (DQK == 128) ? (kr0 & 15) : ((kr0 >> 1) & 7);
  const int kwofs = kr0 * RB + (kch << 4);
  const int klane = kr0 * ldk + ((kch ^ kszw) << 3);
  const int vr0 = tid >> 3, vch = tid & 7, vszw = (vr0 >> 1) & 7;
  const int vwofs = 16384 + vr0 * 128 + (vch << 4);
  const int vlane = vr0 * ldv + ((vch ^ vszw) << 3);
  u32x2 mw = {0u, 0u}, mwn = {0u, 0u};

  int kt = kt_lo;
  if (MODE == 2) { while (kt < nkt && !((kt >> 2) == cur || ((un >> (kt >> 2)) & 1))) ++kt; }
  {
    const int kp = (kt < nkt) ? kt : nkt - 1;
#pragma unroll
    for (int i = 0; i < KCH; ++i) dma16(Kp + (size_t)(kp * 64 + i * RPI) * ldk + klane, smem + kwofs + i * (RPI * RB));
#pragma unroll
    for (int i = 0; i < 4; ++i) dma16(Vt + (size_t)(i * 32) * ldv + kp * 64 + vlane, smem + vwofs + i * 4096);
    if (MODE == 3 && q0 >= 256) mw = *(const u32x2*)(dmask + (size_t)q * 256 + (kp * 2));
  }
  asm volatile("s_waitcnt vmcnt(0)" ::: "memory");
  __syncthreads();
  int buf = 0;
#pragma clang loop unroll(disable)
  while (kt < nkt) {
    int nx = kt + 1;
    if (MODE == 2) { while (nx < nkt && !((nx >> 2) == cur || ((un >> (nx >> 2)) & 1))) ++nx; }
    const bool more = nx < nkt;
    unsigned char* sn = smem + (buf ^ 1) * 32768;
    const int k0 = kt * 64;
    const bool active = (MODE == 0) || (k0 <= qw0 + 31);
    const unsigned char* kb = smem + buf * 32768;
    const unsigned char* vb = kb + 16384;
#pragma unroll
    for (int sub = 0; sub < 2; ++sub) {
      if (active) {
        f32x16 Sx;
#pragma unroll
        for (int i = 0; i < 16; ++i) Sx[i] = 0.f;
#pragma unroll
        for (int kh = 0; kh < NKS; kh += 4) {
          bf16x8 kf[4];
#pragma unroll
          for (int ks = 0; ks < 4; ++ks) kf[ks] = *(const bf16x8*)(kb + (32 * sub + lr) * RB + (((2 * (kh + ks) + lh) ^ swzK) << 4));
          __builtin_amdgcn_sched_barrier(0);
#pragma unroll
          for (int ks = 0; ks < 4; ++ks) Sx = mfma32(kf[ks], qf[kh + ks], Sx);
        }
        bf16x8 vf0[4], vf1[4];
        {
          const int c16 = 4 * sub + lh;
#pragma unroll
          for (int b = 0; b < 4; ++b) vf0[b] = *(const bf16x8*)(vb + (32 * b + lr) * 128 + ((c16 ^ vsw) << 4));
        }
        __builtin_amdgcn_sched_barrier(0);
        float mx = fmaxf(fmaxf(Sx[0], Sx[1]), fmaxf(Sx[2], Sx[3]));
#pragma unroll
        for (int i = 4; i < 16; i += 2) mx = fmaxf(mx, fmaxf(Sx[i], Sx[i + 1]));
        mx = fmaxf(mx, __shfl_xor(mx, 32));
        const float mnew = fmaxf(m, mx);
        const float alpha = __builtin_amdgcn_exp2f((m - mnew) * sc2);
        m = mnew;
        float negm = -mnew * sc2;
        if (MODE == 2) { const int b = k0 >> 8; if (b != cur && !((selw >> b) & 1)) negm = NEG_INF; }
#pragma unroll
        for (int i = 0; i < 16; ++i) Sx[i] = __builtin_amdgcn_exp2f(__builtin_fmaf(Sx[i], sc2, negm));
        if (MODE == 3 && q0 >= 256) {
          const u32 wsh = (sub ? mw.y : mw.x) >> (4 * lh);
#pragma unroll
          for (int i = 0; i < 16; ++i) {
            const int t = __builtin_amdgcn_sbfe((int)wsh, (i & 3) + 8 * (i >> 2), 1);
            Sx[i] = __uint_as_float(__float_as_uint(Sx[i]) & (u32)t);
          }
        } else if (MODE != 0) {
          if (k0 + 32 * sub + 31 > qw0) {
            const int thr = q - k0 - 32 * sub - 4 * lh;
#pragma unroll
            for (int i = 0; i < 16; ++i) Sx[i] = (((i & 3) + 8 * (i >> 2)) > thr) ? 0.f : Sx[i];
          }
        }
        float ls = 0.f;
#pragma unroll
        for (int i = 0; i < 16; ++i) ls += Sx[i];
        l = l * alpha + ls;
        if (__ballot(alpha != 1.0f) != 0ull) {
#pragma unroll
          for (int b = 0; b < 4; ++b)
#pragma unroll
            for (int i = 0; i < 16; ++i) O[b][i] *= alpha;
        }
        {
          const int c16 = 4 * sub + 2 + lh;
#pragma unroll
          for (int b = 0; b < 4; ++b) vf1[b] = *(const bf16x8*)(vb + (32 * b + lr) * 128 + ((c16 ^ vsw) << 4));
        }
        __builtin_amdgcn_sched_barrier(0);
        {
          u32x4 pw = {pack2(Sx[0], Sx[1]), pack2(Sx[2], Sx[3]), pack2(Sx[4], Sx[5]), pack2(Sx[6], Sx[7])};
          const bf16x8 pf = __builtin_bit_cast(bf16x8, pw);
#pragma unroll
          for (int b = 0; b < 4; ++b) O[b] = mfma32(vf0[b], pf, O[b]);
        }
        {
          u32x4 pw = {pack2(Sx[8], Sx[9]), pack2(Sx[10], Sx[11]), pack2(Sx[12], Sx[13]), pack2(Sx[14], Sx[15])};
          const bf16x8 pf = __builtin_bit_cast(bf16x8, pw);
#pragma unroll
          for (int b = 0; b < 4; ++b) O[b] = mfma32(vf1[b], pf, O[b]);
        }
      }
      if (sub == 0 && more) {
#pragma unroll
        for (int i = 0; i < KCH; ++i) dma16(Kp + (size_t)(nx * 64 + i * RPI) * ldk + klane, sn + kwofs + i * (RPI * RB));
#pragma unroll
        for (int i = 0; i < 4; ++i) dma16(Vt + (size_t)(i * 32) * ldv + nx * 64 + vlane, sn + vwofs + i * 4096);
        if (MODE == 3 && q0 >= 256) mwn = *(const u32x2*)(dmask + (size_t)q * 256 + (nx * 2));
      }
    }
    asm volatile("s_waitcnt vmcnt(0)" ::: "memory");
    __syncthreads();
    mw = mwn;
    kt = nx;
    buf ^= 1;
  }
  l_out = l + __shfl_xor(l, 32);
  m_out = m;
}

DI void write_O_bf16(const f32x16 (&O)[4], float linv, u16* __restrict__ out, int ldo, int q) {
  const int lh = (ltid() & 63) >> 5;
#pragma unroll
  for (int b = 0; b < 4; ++b)
#pragma unroll
    for (int g = 0; g < 4; ++g) {
      uint2 w = make_uint2(pack2(O[b][4 * g] * linv, O[b][4 * g + 1] * linv), pack2(O[b][4 * g + 2] * linv, O[b][4 * g + 3] * linv));
      *(uint2*)(out + (size_t)q * ldo + 32 * b + 8 * g + 4 * lh) = w;
    }
}

DI u32 f2key(float f) {
  u32 u = __float_as_uint(f + 0.0f);
  return (u & 0x80000000u) ? ~u : (u | 0x80000000u);
}
DI u32 ld_scr(const u32* p) { return __hip_atomic_load((u32*)p, __ATOMIC_RELAXED, __HIP_MEMORY_SCOPE_AGENT); }

DI void radix_extract(const u32* hrow, int lane, int& kneed, u32& digit_out) {
  int cnt[32];
#pragma unroll
  for (int j = 0; j < 4; ++j) {
    const uint4 v = ((const uint4*)hrow)[lane * 4 + j];
    cnt[8 * j + 0] = (int)(v.x & 0xffffu); cnt[8 * j + 1] = (int)(v.x >> 16);
    cnt[8 * j + 2] = (int)(v.y & 0xffffu); cnt[8 * j + 3] = (int)(v.y >> 16);
    cnt[8 * j + 4] = (int)(v.z & 0xffffu); cnt[8 * j + 5] = (int)(v.z >> 16);
    cnt[8 * j + 6] = (int)(v.w & 0xffffu); cnt[8 * j + 7] = (int)(v.w >> 16);
  }
  int local = 0;
#pragma unroll
  for (int j = 0; j < 32; ++j) local += cnt[j];
  int incl = local;
#pragma unroll
  for (int o = 1; o < 64; o <<= 1) {
    const int v = __shfl_down(incl, o);
    if (lane + o < 64) incl += v;
  }
  const int above = incl - local;
  const bool found = (above < kneed) && (kneed <= incl);
  int digit = 0, newk = 0;
  {
    int cum = above;
    bool done = false;
#pragma unroll
    for (int b = 31; b >= 0; --b) {
      if (!done && cum + cnt[b] >= kneed) { digit = 32 * lane + b; newk = kneed - cum; done = true; }
      cum += cnt[b];
    }
  }
  const u64 fm = __ballot(found);
  const int src = (int)__builtin_ctzll(fm);
  digit_out = (u32)__shfl(digit, src);
  kneed = __shfl(newk, src);
}

DI void dsa_select_item(const Params& p, int rb, unsigned char* smem) {
  const int tid = ltid(), lane = tid & 63, wid = tid >> 6, fr = lane & 15, fq = lane >> 4;
  const int t0 = rb * 16;
  u32* scr = p.scores + (size_t)blockIdx.x * (16 * 8192);
  u32* hist0 = (u32*)smem;
#pragma unroll
  for (int j = 0; j < 16; ++j) ((uint4*)hist0)[tid + 256 * j] = make_uint4(0, 0, 0, 0);
  __syncthreads();
  {
    const u16* iq = p.proj + C_IQ;
    const u16* ik = p.proj + C_IK;
    bf16x8 qa[8][2];
#pragma unroll
    for (int hd = 0; hd < 8; ++hd)
#pragma unroll
      for (int ks = 0; ks < 2; ++ks) qa[hd][ks] = *(const bf16x8*)(iq + (size_t)(t0 + fr) * DIN + hd * 64 + ks * 32 + fq * 8);
    float w[4][8];
#pragma unroll
    for (int j = 0; j < 4; ++j) {
      const float4* wp = (const float4*)(p.iw + (size_t)(t0 + 4 * fq + j) * 8);
      float4 a = wp[0], b = wp[1];
      w[j][0] = a.x; w[j][1] = a.y; w[j][2] = a.z; w[j][3] = a.w; w[j][4] = b.x; w[j][5] = b.y; w[j][6] = b.z; w[j][7] = b.w;
    }
    const int ntile = rb + 1, last = ntile - 1;
    bf16x8 c0, c1, a0, a1, b0, b1;
    {
      const int k0 = (wid < ntile ? wid : last) * 16, k1 = (wid + 4 < ntile ? wid + 4 : last) * 16, k2 = (wid + 8 < ntile ? wid + 8 : last) * 16;
      c0 = *(const bf16x8*)(ik + (size_t)(k0 + fr) * DIN + fq * 8); c1 = *(const bf16x8*)(ik + (size_t)(k0 + fr) * DIN + 32 + fq * 8);
      a0 = *(const bf16x8*)(ik + (size_t)(k1 + fr) * DIN + fq * 8); a1 = *(const bf16x8*)(ik + (size_t)(k1 + fr) * DIN + 32 + fq * 8);
      b0 = *(const bf16x8*)(ik + (size_t)(k2 + fr) * DIN + fq * 8); b1 = *(const bf16x8*)(ik + (size_t)(k2 + fr) * DIN + 32 + fq * 8);
    }
    for (int kt = wid; kt < ntile; kt += 4) {
      const int k0 = kt * 16;
      const bf16x8 kb0 = c0, kb1 = c1;
      c0 = a0; c1 = a1; a0 = b0; a1 = b1;
      {
        const int kn = (kt + 12 < ntile ? kt + 12 : last) * 16;
        b0 = *(const bf16x8*)(ik + (size_t)(kn + fr) * DIN + fq * 8);
        b1 = *(const bf16x8*)(ik + (size_t)(kn + fr) * DIN + 32 + fq * 8);
      }
      float sc[4] = {0.f, 0.f, 0.f, 0.f};
#pragma unroll
      for (int hd = 0; hd < 8; ++hd) {
        f32x4 c = {0.f, 0.f, 0.f, 0.f};
        c = mfma16(qa[hd][0], kb0, c);
        c = mfma16(qa[hd][1], kb1, c);
#pragma unroll
        for (int j = 0; j < 4; ++j) sc[j] += w[j][hd] * fmaxf(c[j], 0.f);
      }
#pragma unroll
      for (int j = 0; j < 4; ++j) {
        const int row = 4 * fq + j, key = k0 + fr;
        const bool adm = key <= t0 + row;
        const u32 kk = adm ? f2key(sc[j]) : 0u;
        scr[row * 8192 + key] = kk;
        if (adm) atomicAdd(&hist0[row * 1024 + (kk >> 22)], 1u << ((kk >> 17) & 16u));
      }
    }
  }
  asm volatile("s_waitcnt vmcnt(0)" ::: "memory");
  __syncthreads();
  __builtin_amdgcn_fence(__ATOMIC_ACQUIRE, "agent");
  u32* hist = (u32*)smem + wid * 4096;
  const int rowb = 4 * wid;
  const u32* sr0 = scr + rowb * 8192;
  const int nbase = t0 + rowb + 1;
  const int nmax = nbase + 3;
  u32 prefix[4] = {0u, 0u, 0u, 0u};
  int kneed[4] = {256, 256, 256, 256};
#pragma unroll
  for (int rr = 0; rr < 4; ++rr) { u32 d; radix_extract(hist0 + (rowb + rr) * 1024, lane, kneed[rr], d); prefix[rr] = d; }
  __syncthreads();
#pragma unroll 1
  for (int pass = 1; pass < 3; ++pass) {
    const int sh = (pass == 1) ? 10 : 0, msh = (pass == 1) ? 21 : 10;
    const u32 dmsk = (pass == 1) ? 2047u : 1023u;
#pragma unroll
    for (int j = 0; j < 16; ++j) ((uint4*)hist)[lane + 64 * j] = make_uint4(0, 0, 0, 0);
    __threadfence_block();
    for (int c0 = lane; c0 < nmax; c0 += 512) {
      u32 kk[4][8];
#pragma unroll
      for (int rr = 0; rr < 4; ++rr)
#pragma unroll
        for (int j = 0; j < 8; ++j) { const int c = c0 + 64 * j; kk[rr][j] = (c < nbase + rr) ? sr0[rr * 8192 + c] : 0u; }
#pragma unroll
      for (int rr = 0; rr < 4; ++rr)
#pragma unroll
        for (int j = 0; j < 8; ++j) {
          const int c = c0 + 64 * j;
          const u32 k = kk[rr][j];
          const bool mt = (c < nbase + rr) && ((k >> msh) == prefix[rr]);
          const u32 bin = (k >> sh) & dmsk;
          if (mt) atomicAdd(&hist[rr * 1024 + (bin >> 1)], 1u << ((bin & 1u) << 4));
        }
    }
    __threadfence_block();
#pragma unroll
    for (int rr = 0; rr < 4; ++rr) {
      u32 d;
      radix_extract(hist + rr * 1024, lane, kneed[rr], d);
      prefix[rr] = (prefix[rr] << ((pass == 1) ? 11 : 10)) | d;
    }
    __threadfence_block();
  }
  {
    int taken[4] = {0, 0, 0, 0};
    const int kend = ((t0 + rowb) | 127) + 1;
    for (int cb = 0; cb < kend; cb += 256) {
      u32 kk[4][4];
#pragma unroll
      for (int rr = 0; rr < 4; ++rr)
#pragma unroll
        for (int j = 0; j < 4; ++j) { const int c = cb + 64 * j + lane; kk[rr][j] = (c < nbase + rr) ? __builtin_nontemporal_load(sr0 + rr * 8192 + c) : 0u; }
#pragma unroll
      for (int rr = 0; rr < 4; ++rr) {
        const u32 T = prefix[rr];
#pragma unroll
        for (int j = 0; j < 4; ++j) {
          const int c0 = cb + 64 * j, c = c0 + lane;
          const u32 k = kk[rr][j];
          const bool gt = k > T, eq = (c < nbase + rr) && (k == T);
          const u64 eqm = __ballot(eq);
          const int rank = taken[rr] + __builtin_popcountll(eqm & ((1ull << lane) - 1ull));
          const bool sel = gt || (eq && rank < kneed[rr]);
          taken[rr] += __builtin_popcountll(eqm);
          const u64 sm = __ballot(sel);
          if (lane == 0 && c0 < kend) *(u64*)(p.dmask + (size_t)(t0 + rowb + rr) * 256 + (c0 >> 5)) = sm;
        }
      }
    }
  }
}

enum { PH_PREP = 0, PH_WIN, PH_MIX1, PH_MIX2, PH_WOUT, PH_NORM2, PH_CQ, PH_CROSS, PH_CO, PH_NORM3, PH_UP, PH_CONV, PH_DOWN, PH_COUNT };

DI void convert_matrix(const float* W, int K, int N, int Npad, u16* Wt, unsigned char* smem) {
  const int nkt = K / 64, cnt = nkt * (Npad / 128);
  for (int t = blockIdx.x; t < cnt; t += gridDim.x) convert_tile(W, K, N, Wt, t % nkt, t / nkt, (float*)smem);
}

DI void phase_prep(const Params& p, int layer, unsigned char* smem) {
  constexpr int T0 = (D_ / 64) * (DINP / 128), T1 = T0 + (D_ / 64) * (D_ / 128), T2 = T1 + (D_ / 64) * (512 / 128),
                T3 = T2 + (D_ / 64) * (1024 / 128), T4 = T3 + (512 / 64) * (D_ / 128), T5 = T4 + (D_ / 64) * (DFF2 / 128),
                T6 = T5 + (DFF / 64) * (D_ / 128);
  for (int t = lbid(); t < T6; t += gridDim.x) {
    const float* W; u16* Wt; int K, N, tt;
    if (t < T0) { W = p.w_in + (size_t)layer * D_ * DIN; Wt = p.wt_in; K = D_; N = DIN; tt = t; }
    else if (t < T1) { W = p.w_out + (size_t)layer * D_ * D_; Wt = p.wt_out; K = D_; N = D_; tt = t - T0; }
    else if (t < T2) { W = p.cross_wq + (size_t)layer * D_ * 512; Wt = p.wt_cq; K = D_; N = 512; tt = t - T1; }
    else if (t < T3) { W = p.cross_wkv + (size_t)layer * D_ * 1024; Wt = p.wt_ckv; K = D_; N = 1024; tt = t - T2; }
    else if (t < T4) { W = p.cross_wo + (size_t)layer * 512 * D_; Wt = p.wt_co; K = 512; N = D_; tt = t - T3; }
    else if (t < T5) { W = p.w_up + (size_t)layer * D_ * DFF2; Wt = p.wt_up; K = D_; N = DFF2; tt = t - T4; }
    else { W = p.w_down + (size_t)layer * DFF * D_; Wt = p.wt_down; K = DFF; N = D_; tt = t - T5; }
    const int nkt = K / 64;
    convert_tile(W, K, N, Wt, tt % nkt, tt / nkt, (float*)smem);
  }
  const float* xsrc = (layer == 0) ? p.x : p.out;
  const int wv = ltid() >> 6;
  for (int r = blockIdx.x * 4 + wv; r < S_ + MEML; r += gridDim.x * 4) {
    if (r < S_) rownorm(xsrc, p.attn_norm + layer * D_, p.hbuf, r);
    else rownorm(p.mem, p.mem_norm + layer * D_, p.mnorm, r - S_);
  }
}

DI void phase_norm(const Params& p, const float* g) {
  const int wv = ltid() >> 6;
  for (int r = blockIdx.x * 4 + wv; r < S_; r += gridDim.x * 4) rownorm(p.out, g, p.hbuf, r);
}

DI void phase_win(const Params& p, int layer, unsigned char* smem, int* ctr) {
  const int ntile = 64 * 53 + 16;
  for (int it = lbid(); it < ntile; it += gridDim.x) {
    __syncthreads();
    EpiStage es; es.gain = nullptr; es.out = p.proj; es.ldo = DIN; es.col = 0; es.vt = nullptr; es.vtS = S_; es.kind = K_RAW;
    if (it < 64 * 53) {
      const int mt = it & 63, nt = it >> 6, n0 = nt * 128;
      es.col = n0;
      if (n0 < C_MK) { es.kind = K_NR128; es.gain = p.moba_g + layer * 256; }
      else if (n0 < C_MV) { es.kind = K_NR128; es.gain = p.moba_g + layer * 256 + 128; }
      else if (n0 < C_DQ) { es.kind = K_VT; es.vt = p.vT + (size_t)((n0 - C_MV) >> 7) * 128 * S_; }
      else if (n0 < C_DK) { es.kind = K_NR64; es.gain = p.diff_g + layer * 128; }
      else if (n0 < C_DV) { es.kind = K_NR64; es.gain = p.diff_g + layer * 128 + 64; }
      else if (n0 < C_SQ) { es.kind = K_VT; es.vt = p.vT + (size_t)(6 + ((n0 - C_DV) >> 7)) * 128 * S_; }
      else if (n0 < C_SK) { es.kind = K_NR128; es.gain = p.dsa_g + layer * 256; }
      else if (n0 < C_SV) { es.kind = K_NR128; es.gain = p.dsa_g + layer * 256 + 128; }
      else if (n0 < C_IQ) { es.kind = K_VT; es.vt = p.vT + (size_t)(10 + ((n0 - C_SV) >> 7)) * 128 * S_; }
      else if (n0 < C_IK) { es.kind = K_R64; }
      else { es.kind = K_IKIW; }
      gemm_tile<0>(p, p.hbuf, D_, p.wt_in, D_, D_, mt * 128, n0, smem, es, nullptr, nullptr);
    } else {
      const int j = it - 64 * 53, mt = j & 1, nt = j >> 1;
      if (nt < 4) { es.kind = K_N128; es.gain = p.cross_g + layer * 256 + 128; es.out = p.ck; es.ldo = 512; es.col = nt * 128; }
      else { es.kind = K_VT; es.vt = p.cvT + (size_t)(nt - 4) * 128 * MEML; es.vtS = MEML; }
      gemm_tile<0>(p, p.mnorm, D_, p.wt_ckv, D_, D_, mt * 128, nt * 128, smem, es, nullptr, nullptr);
    }
  }
}

constexpr int PB_ROW = 272, PB_PART = 128 * PB_ROW, PB_SLOT = 2 * PB_PART;
DI void split_order(int s, int& qt, int& part, int& nparts) {
  if (s < 80) {
    const int g = s / 5, k = s % 5;
    if (k == 0) { qt = 31 - g; part = 0; nparts = 1; }
    else { qt = 63 - 2 * g - ((k - 1) >> 1); part = (k - 1) & 1; nparts = 2; }
  } else { qt = 15 - (s - 80); part = 0; nparts = 1; }
}
DI void st_wt(void* p, u32 lo, u32 hi) {
  __hip_atomic_store((u64*)p, (u64)lo | ((u64)hi << 32), __ATOMIC_RELAXED, __HIP_MEMORY_SCOPE_AGENT);
}
DI u64 ld_wt(const void* p) { return __hip_atomic_load((u64*)p, __ATOMIC_RELAXED, __HIP_MEMORY_SCOPE_AGENT); }
DI bool split_finish(f32x16 (&O)[4], float& m, float& l, float sc2, unsigned char* pslot, int part, int* flag, unsigned char* smem) {
  const int lane = ltid() & 63, wid = ltid() >> 6, lr = lane & 31, lh = lane >> 5;
  const int ql = 32 * wid + lr;
  unsigned char* mine = pslot + part * PB_PART + ql * PB_ROW;
#pragma unroll
  for (int b = 0; b < 4; ++b)
#pragma unroll
    for (int g = 0; g < 4; ++g)
      st_wt(mine + (32 * b + 8 * g + 4 * lh) * 2, pack2(O[b][4 * g], O[b][4 * g + 1]), pack2(O[b][4 * g + 2], O[b][4 * g + 3]));
  if (lh == 0) st_wt(mine + 256, __float_as_uint(m), __float_as_uint(l));
  asm volatile("s_waitcnt vmcnt(0)" ::: "memory");
  __syncthreads();
  if (ltid() == 0) ((volatile int*)smem)[2] = atomicAdd(flag, 1);
  __syncthreads();
  const int old = ((volatile int*)smem)[2];
  if (old == 0) return false;
  const unsigned char* oth = pslot + (part ^ 1) * PB_PART + ql * PB_ROW;
  const u64 mlw = ld_wt(oth + 256);
  const float m2 = __uint_as_float((u32)mlw), l2 = __uint_as_float((u32)(mlw >> 32));
  const float M = fmaxf(m, m2);
  const float a = __builtin_amdgcn_exp2f((m - M) * sc2), bb = __builtin_amdgcn_exp2f((m2 - M) * sc2);
#pragma unroll
  for (int b = 0; b < 4; ++b)
#pragma unroll
    for (int g = 0; g < 4; ++g) {
      const u64 w = ld_wt(oth + (32 * b + 8 * g + 4 * lh) * 2);
      const u32 wx = (u32)w, wy = (u32)(w >> 32);
      const u32 o0 = pack2(O[b][4 * g], O[b][4 * g + 1]), o1 = pack2(O[b][4 * g + 2], O[b][4 * g + 3]);
      O[b][4 * g] = a * bflo(o0) + bb * bflo(wx);
      O[b][4 * g + 1] = a * bfhi(o0) + bb * bfhi(wx);
      O[b][4 * g + 2] = a * bflo(o1) + bb * bflo(wy);
      O[b][4 * g + 3] = a * bfhi(o1) + bb * bfhi(wy);
    }
  l = a * l + bb * l2;
  m = M;
  return true;
}

DI void kbar_item(const Params& p, int idx, unsigned char* smem) {
  const int n = idx / 6, hd = idx % 6, tid = ltid(), d = tid & 127, hf = tid >> 7;
  const u16* kp = p.proj + (size_t)(n * 256 + hf * 128) * DIN + C_MK + hd * 128 + d;
  float s = 0.f;
  for (int j = 0; j < 128; ++j) s += __uint_as_float(((u32)kp[(size_t)j * DIN]) << 16);
  float* sm = (float*)smem + 16;
  if (hf) sm[d] = s;
  __syncthreads();
  if (!hf) p.kbar[(size_t)(n * 6 + hd) * 128 + d] = (s + sm[d]) * (1.0f / 256.0f);
}

DI void diff_item(const Params& p, int layer, int qt, int hh, int c, int part, int nparts, unsigned char* smem) {
  f32x16 O[4];
  float l, m;
  const int q0 = qt * 128, nk = 2 * qt + 2;
  const int lo = (nparts == 2 && part == 1) ? qt + 1 : 0, hi = (nparts == 2 && part == 0) ? qt + 1 : nk;
  const float sc2 = 0.125f * 1.4426950408889634f;
  attn_core<64, 1, DIN, DIN, S_>(p.proj + C_DQ + hh * 128 + c * 64, p.proj + C_DK + hh * 128 + c * 64, p.vT + (size_t)(6 + hh) * 128 * S_,
                   q0, lo, hi, sc2, nullptr, nullptr, smem, O, l, m);
  if (nparts == 2) {
    const int slot = (qt - 32) * 8 + hh * 2 + c;
    if (!split_finish(O, m, l, sc2, (unsigned char*)p.mixed + (size_t)slot * PB_SLOT, part, p.counters + 512 + layer * 1024 + slot, smem)) return;
  }
  const float linv = 1.0f / l;
  const int lane = ltid() & 63, wid = ltid() >> 6, lr = lane & 31, lh = lane >> 5;
  const int q = q0 + 32 * wid + lr;
  float* dst = p.dscr + ((size_t)(c * 4 + hh) * S_ + q) * 128;
#pragma unroll
  for (int b = 0; b < 4; ++b)
#pragma unroll
    for (int g = 0; g < 4; ++g)
      *(float4*)(dst + 32 * b + 8 * g + 4 * lh) =
          make_float4(O[b][4 * g] * linv, O[b][4 * g + 1] * linv, O[b][4 * g + 2] * linv, O[b][4 * g + 3] * linv);
}

DI void diff_combine_item(const Params& p, int layer, int qt, int hh) {
  const float* lf = p.diff_lam + layer * 256;
  float s1 = 0.f, s2 = 0.f;
  for (int j = 0; j < 64; ++j) { s1 += lf[j] * lf[64 + j]; s2 += lf[128 + j] * lf[192 + j]; }
  const float lam_init = (layer == 0) ? 0.2f : (0.8f - 0.6f * 0.74081822068171788f);
  const float lam = __expf(s1) - __expf(s2) + lam_init;
  const int tid = ltid(), r = tid >> 1, hf = tid & 1;
  const int q = qt * 128 + r;
  const float* o1 = p.dscr + ((size_t)(0 * 4 + hh) * S_ + q) * 128 + 64 * hf;
  const float* o2 = p.dscr + ((size_t)(1 * 4 + hh) * S_ + q) * 128 + 64 * hf;
  float a[64];
  float ss = 0.f;
#pragma unroll
  for (int j = 0; j < 16; ++j) {
    float4 u = ((const float4*)o1)[j], v = ((const float4*)o2)[j];
    a[4 * j] = u.x - lam * v.x; a[4 * j + 1] = u.y - lam * v.y; a[4 * j + 2] = u.z - lam * v.z; a[4 * j + 3] = u.w - lam * v.w;
    ss += a[4 * j] * a[4 * j] + a[4 * j + 1] * a[4 * j + 1] + a[4 * j + 2] * a[4 * j + 2] + a[4 * j + 3] * a[4 * j + 3];
  }
  ss += __shfl_xor(ss, 1);
  const float rs = rsqrtf(ss * (1.0f / 128) + 1e-6f) * (1.0f - lam_init);
  const float* g = p.diff_subln + layer * 128 + 64 * hf;
  uint4* dst = (uint4*)(p.mixed + (size_t)q * D_ + 768 + hh * 128 + 64 * hf);
#pragma unroll
  for (int j = 0; j < 8; ++j)
    dst[j] = make_uint4(pack2(a[8 * j] * rs * g[8 * j], a[8 * j + 1] * rs * g[8 * j + 1]),
                        pack2(a[8 * j + 2] * rs * g[8 * j + 2], a[8 * j + 3] * rs * g[8 * j + 3]),
                        pack2(a[8 * j + 4] * rs * g[8 * j + 4], a[8 * j + 5] * rs * g[8 * j + 5]),
                        pack2(a[8 * j + 6] * rs * g[8 * j + 6], a[8 * j + 7] * rs * g[8 * j + 7]));
}

DI void phase_mix1(const Params& p, int layer, unsigned char* smem, int* ctrA, int* ctrB) {
  if (blockIdx.x < SEL_BLOCKS) {
    for (;;) {
      const int it = next_item(ctrA, smem);
      if (it >= 512 - 16) break;
      dsa_select_item(p, 511 - it, smem);
    }
  }
  for (;;) {
    const int it = next_item(ctrB, smem);
    if (it >= 768 + 192) break;
    if (it < 768) {
      int qt, part, nparts;
      split_order(it >> 3, qt, part, nparts);
      diff_item(p, layer, qt, (it & 7) >> 1, it & 1, part, nparts, smem);
    } else kbar_item(p, it - 768, smem);
  }
}

DI void phase_mix2(const Params& p, int layer, unsigned char* smem, int* ctr) {
  const float sc2 = 0.08838834764831845f * 1.4426950408889634f;
  for (;;) {
    const int it = next_item(ctr, smem);
    if (it >= 1152 + 256) break;
    if (it < 1152) {
      int qt, part, nparts;
      const int wh = it % 12;
      split_order(it / 12, qt, part, nparts);
      const int q0 = qt * 128, nk = 2 * qt + 2;
      const int lo = (nparts == 2 && part == 1) ? qt + 1 : 0, hi = (nparts == 2 && part == 0) ? qt + 1 : nk;
      f32x16 O[4];
      float l, m;
      const int lane = ltid() & 63, wid = ltid() >> 6;
      const int q = q0 + 32 * wid + (lane & 31);
      if (wh < 6) {
        attn_core<128, 2, DIN, DIN, S_>(p.proj + C_MQ + wh * 128, p.proj + C_MK + wh * 128, p.vT + (size_t)wh * 128 * S_, q0,
                          lo, hi, sc2, nullptr, p.kbar + wh * 128, smem, O, l, m);
      } else {
        const int hd = wh - 6;
        attn_core<128, 3, DIN, DIN, S_>(p.proj + C_SQ + hd * 128, p.proj + C_SK + hd * 128, p.vT + (size_t)(10 + hd) * 128 * S_, q0,
                          lo, hi, sc2, p.dmask, nullptr, smem, O, l, m);
      }
      bool fin = true;
      if (nparts == 2) {
        const int slot = (qt - 32) * 12 + wh;
        fin = split_finish(O, m, l, sc2, (unsigned char*)p.scores + (size_t)slot * PB_SLOT, part, p.counters + 512 + layer * 1024 + 512 + slot, smem);
      }
      if (fin) write_O_bf16(O, 1.0f / l, p.mixed + (wh < 6 ? wh * 128 : 1280 + (wh - 6) * 128), D_, q);
    } else {
      const int j = it - 1152;
      diff_combine_item(p, layer, j >> 2, j & 3);
    }
  }
}

DI void phase_gemm_res(const Params& p, const u16* A, int lda, const u16* Bt, int K, const float* res, unsigned char* smem, int* ctr) {
  EpiStage es{};
  for (int it = lbid(); it < 64 * 16; it += gridDim.x) {
    __syncthreads();
    gemm_tile<1>(p, A, lda, Bt, K, K, (it & 63) * 128, (it >> 6) * 128, smem, es, res, p.out);
  }
}

DI void phase_cq(const Params& p, int layer, unsigned char* smem, int* ctr) {
  for (int it = lbid(); it < 64 * 4; it += gridDim.x) {
    __syncthreads();
    const int qt = it & 63, h = it >> 6, q0 = qt * 128;
    EpiStage es; es.kind = K_N128; es.gain = p.cross_g + layer * 256; es.out = p.cq; es.ldo = 512; es.col = h * 128; es.vt = nullptr; es.vtS = 0;
    gemm_tile<0>(p, p.hbuf, D_, p.wt_cq, D_, D_, q0, h * 128, smem, es, nullptr, nullptr);
    asm volatile("s_waitcnt vmcnt(0)" ::: "memory");
    __syncthreads();
    f32x16 O[4];
    float l, mdummy;
    attn_core<128, 0, 512, 512, MEML>(p.cq + h * 128, p.ck + h * 128, p.cvT + (size_t)h * 128 * MEML, q0, 0, 4,
                      0.08838834764831845f * 1.4426950408889634f, nullptr, nullptr, smem, O, l, mdummy);
    const int lane = ltid() & 63, wid = ltid() >> 6;
    write_O_bf16(O, 1.0f / l, p.co + h * 128, 512, q0 + 32 * wid + (lane & 31));
  }
}

DI void phase_cross(const Params& p, unsigned char* smem, int* ctr) {
  for (int it = lbid(); it < 256; it += gridDim.x) {
    __syncthreads();
    const int qt = it >> 2, h = it & 3, q0 = qt * 128;
    f32x16 O[4];
    float l;
    float mdummy;
    attn_core<128, 0, 512, 512, MEML>(p.cq + h * 128, p.ck + h * 128, p.cvT + (size_t)h * 128 * MEML, q0, 0, 4,
                      0.08838834764831845f * 1.4426950408889634f, nullptr, nullptr, smem, O, l, mdummy);
    const int lane = ltid() & 63, wid = ltid() >> 6;
    write_O_bf16(O, 1.0f / l, p.co + h * 128, 512, q0 + 32 * wid + (lane & 31));
  }
}

DI void phase_up(const Params& p, unsigned char* smem, int* ctr) {
  for (int it = lbid(); it < 64 * 86; it += gridDim.x) {
    __syncthreads();
    EpiStage es; es.kind = K_RAW; es.gain = nullptr; es.out = p.ubuf; es.ldo = DFF2; es.col = (it >> 6) * 128; es.vt = nullptr; es.vtS = 0;
    gemm_tile<0>(p, p.hbuf, D_, p.wt_up, D_, D_, (it & 63) * 128, (it >> 6) * 128, smem, es, nullptr, nullptr);
  }
}

DI uint4 ldnt16(const u16* p) { const u32x4 v = __builtin_nontemporal_load((const u32x4*)p); return make_uint4(v[0], v[1], v[2], v[3]); }
DI void unpack8(uint4 a, float (&o)[8]) {
  o[0] = bflo(a.x); o[1] = bfhi(a.x); o[2] = bflo(a.y); o[3] = bfhi(a.y); o[4] = bflo(a.z); o[5] = bfhi(a.z); o[6] = bflo(a.w); o[7] = bfhi(a.w);
}

DI void phase_conv(const Params& p, int layer, unsigned char* smem, int* ctr) {
  const float* cw = p.conv_w + (size_t)layer * 3 * DFF2;
  const float* cb = p.conv_b + (size_t)layer * DFF2;
  for (int it = lbid(); it < 512; it += gridDim.x) {
    const int t0 = it * 16;
    for (int cg8 = ltid(); cg8 < DFF / 8; cg8 += NTHR) {
      const int j0 = cg8 * 8;
      float wg[3][8], wv[3][8], bg[8], bv[8];
#pragma unroll
      for (int d = 0; d < 3; ++d)
#pragma unroll
        for (int e = 0; e < 8; ++e) { wg[d][e] = cw[d * DFF2 + j0 + e]; wv[d][e] = cw[d * DFF2 + DFF + j0 + e]; }
#pragma unroll
      for (int e = 0; e < 8; ++e) { bg[e] = cb[j0 + e]; bv[e] = cb[DFF + j0 + e]; }
      float g2[8], g1[8], v2[8], v1[8];
#pragma unroll
      for (int e = 0; e < 8; ++e) { g2[e] = 0.f; g1[e] = 0.f; v2[e] = 0.f; v1[e] = 0.f; }
      if (t0 >= 2) {
        unpack8(ldnt16(p.ubuf + (size_t)(t0 - 2) * DFF2 + j0), g2);
        unpack8(ldnt16(p.ubuf + (size_t)(t0 - 2) * DFF2 + DFF + j0), v2);
        unpack8(ldnt16(p.ubuf + (size_t)(t0 - 1) * DFF2 + j0), g1);
        unpack8(ldnt16(p.ubuf + (size_t)(t0 - 1) * DFF2 + DFF + j0), v1);
      }
#pragma unroll 8
      for (int r = 0; r < 16; ++r) {
        const int t = t0 + r;
        float g0[8], v0[8], o[8];
        unpack8(ldnt16(p.ubuf + (size_t)t * DFF2 + j0), g0);
        unpack8(ldnt16(p.ubuf + (size_t)t * DFF2 + DFF + j0), v0);
#pragma unroll
        for (int e = 0; e < 8; ++e) {
          const float gg = wg[0][e] * g2[e] + wg[1][e] * g1[e] + wg[2][e] * g0[e] + bg[e];
          const float vv = wv[0][e] * v2[e] + wv[1][e] * v1[e] + wv[2][e] * v0[e] + bv[e];
          o[e] = gg / (1.0f + __expf(-gg)) * vv;
          g2[e] = g1[e]; g1[e] = g0[e]; v2[e] = v1[e]; v1[e] = v0[e];
        }
        *(uint4*)(p.act + (size_t)t * DFF + j0) = make_uint4(pack2(o[0], o[1]), pack2(o[2], o[3]), pack2(o[4], o[5]), pack2(o[6], o[7]));
      }
    }
  }
}

template <int PH>
DI void run_phase(const Params& p, int layer, unsigned char* smem, int cofs = 0) {
  int* ctr = p.counters + (layer * 16 + PH) + cofs;
  if (PH == PH_PREP) phase_prep(p, layer, smem);
  if (PH == PH_WIN) phase_win(p, layer, smem, ctr);
  if (PH == PH_MIX1) phase_mix1(p, layer, smem, ctr, p.counters + (layer * 16 + 14) + cofs);
  if (PH == PH_MIX2) phase_mix2(p, layer, smem, ctr);
  if (PH == PH_WOUT) phase_gemm_res(p, p.mixed, D_, p.wt_out, D_, (layer == 0) ? p.x : p.out, smem, ctr);
  if (PH == PH_NORM2) phase_norm(p, p.cross_norm + layer * D_);
  if (PH == PH_CQ) phase_cq(p, layer, smem, ctr);
  if (PH == PH_CROSS) phase_cross(p, smem, ctr);
  if (PH == PH_CO) phase_gemm_res(p, p.co, 512, p.wt_co, 512, p.out, smem, ctr);
  if (PH == PH_NORM3) phase_norm(p, p.ffn_norm + layer * D_);
  if (PH == PH_UP) phase_up(p, smem, ctr);
  if (PH == PH_CONV) phase_conv(p, layer, smem, ctr);
  if (PH == PH_DOWN) phase_gemm_res(p, p.act, DFF, p.wt_down, DFF, p.out, smem, ctr);
}


#define XB_TMO      128
#define XB_XCNT(j)  (256  + 64 * (j))
#define XB_XSUB(j)  (1280 + 64 * (j))
#define XB_XGEN(j)  (2304 + 64 * (j))
#define XB_TOP      3328
#define XB_TOPGEN   3392
#define XCD_BAR_WORDS 3456
#define XB_SPIN_CAP (1u << 20)
DI unsigned xb_ld(unsigned* p) { return __hip_atomic_load(p, __ATOMIC_RELAXED, __HIP_MEMORY_SCOPE_AGENT); }
DI unsigned xb_add(unsigned* p, unsigned v) { return __hip_atomic_fetch_add(p, v, __ATOMIC_RELAXED, __HIP_MEMORY_SCOPE_AGENT); }
DI unsigned xb_xcc_id() { return (unsigned)__builtin_amdgcn_s_getreg((3 << 11) | 20) & 0xFu; }
#define XB_SPIN(cond, bar) do { unsigned _sp = 0; while (cond) { __builtin_amdgcn_s_sleep(1); \
    if ((++_sp & 255u) == 0u) { if (xb_ld(&(bar)[XB_TMO])) break; if (_sp > XB_SPIN_CAP) { atomicAdd(&(bar)[XB_TMO], 1u); break; } } } } while (0)

DI void xb_init(unsigned* bar) {
  const int t = __builtin_amdgcn_workitem_id_x();
  if (t == 0) {
    const unsigned x = xb_xcc_id();
    (void)xb_add(&bar[XB_XCNT(x)], 1u);
    const unsigned G = gridDim.x;
    unsigned sum, cnt, mine, sp = 0u;
    for (;;) {
      sum = 0u; cnt = 0u; mine = 0u;
#pragma unroll
      for (unsigned j = 0; j < 16; ++j) { const unsigned c = xb_ld(&bar[XB_XCNT(j)]); sum += c; cnt += (c > 0u) ? 1u : 0u; mine = (j == x) ? c : mine; }
      if (sum == G) break;
      __builtin_amdgcn_s_sleep(1);
      if ((++sp & 255u) == 0u) { if (xb_ld(&bar[XB_TMO])) break; if (sp > XB_SPIN_CAP) { atomicAdd(&bar[XB_TMO], 1u); break; } }
    }
    const int bid = lbid();
    bar[XCD_BAR_WORDS + 2 * bid] = mine > 0u ? mine : 1u;
    bar[XCD_BAR_WORDS + 2 * bid + 1] = cnt > 0u ? cnt : 1u;
  }
  __syncthreads();
}

DI void xcd_barrier(unsigned* bar) {
  asm volatile("s_waitcnt vmcnt(0)" ::: "memory");
  __syncthreads();
  if (__builtin_amdgcn_workitem_id_x() == 0) {
    __builtin_amdgcn_s_waitcnt(0);
    const unsigned x = xb_xcc_id();
    const int bid = lbid();
    const unsigned nloc = bar[XCD_BAR_WORDS + 2 * bid], nx = bar[XCD_BAR_WORDS + 2 * bid + 1];
    const unsigned old = xb_add(&bar[XB_XSUB(x)], 1u);
    const unsigned gen = old / nloc;
    if (old + 1u == (gen + 1u) * nloc) {
      __builtin_amdgcn_fence(__ATOMIC_RELEASE, "agent");
      asm volatile("s_waitcnt vmcnt(0)" ::: "memory");
      const unsigned og = xb_add(&bar[XB_TOP], 1u);
      const unsigned tg = og / nx;
      if (og + 1u == (tg + 1u) * nx) xb_add(&bar[XB_TOPGEN], 1u);
      else XB_SPIN(xb_ld(&bar[XB_TOPGEN]) == tg, bar);
      __builtin_amdgcn_fence(__ATOMIC_ACQUIRE, "agent");
      xb_add(&bar[XB_XGEN(x)], 1u);
      asm volatile("s_waitcnt vmcnt(0)" ::: "memory");
    } else {
      XB_SPIN(xb_ld(&bar[XB_XGEN(x)]) == gen, bar);
      __builtin_amdgcn_fence(__ATOMIC_ACQUIRE, "agent");
      asm volatile("s_waitcnt vmcnt(0)" ::: "memory");
    }
  }
  __syncthreads();
}

typedef const Params __attribute__((address_space(4)))* CP4;
DI const Params& launder() {
  CP4 q = (CP4)__builtin_amdgcn_kernarg_segment_ptr();
  asm volatile("" : "+s"(q));
  return *(const Params*)q;
}

#if MULTI
template <int PH>
__global__ void __launch_bounds__(NTHR, 2) phase_kernel(Params p, int layer) {
  __shared__ __attribute__((aligned(16))) unsigned char smem[65536];
  run_phase<PH>(p, layer, smem);
}
#else
__global__ void __launch_bounds__(NTHR, 2) mega_kernel(Params p) {
  __shared__ __attribute__((aligned(16))) unsigned char smem[65536];
  cg::grid_group grid = cg::this_grid();
  xb_init(launder().bar);
#define SEAM() xcd_barrier(launder().bar)
#pragma unroll 1
  for (int layer = 0; layer < 2; ++layer) {
    run_phase<PH_PREP>(launder(), layer, smem);
    SEAM();
    if (launder().counters == nullptr) grid.sync();
    run_phase<PH_WIN>(launder(), layer, smem); SEAM();
    run_phase<PH_MIX1>(launder(), layer, smem); SEAM();
    run_phase<PH_MIX2>(launder(), layer, smem); SEAM();
    run_phase<PH_WOUT>(launder(), layer, smem); SEAM();
    run_phase<PH_NORM2>(launder(), layer, smem); SEAM();
    run_phase<PH_CQ>(launder(), layer, smem); SEAM();
    run_phase<PH_CO>(launder(), layer, smem); SEAM();
    run_phase<PH_NORM3>(launder(), layer, smem); SEAM();
    run_phase<PH_UP>(launder(), layer, smem); SEAM();
    run_phase<PH_CONV>(launder(), layer, smem); SEAM();
    run_phase<PH_DOWN>(launder(), layer, smem);
    if (layer == 0) SEAM();
  }
}
#endif

static size_t alignup(size_t v) { return (v + 255) & ~(size_t)255; }

extern "C" void kernel_launch(void* const* d_in, const int* in_sizes, int n_in, void* d_out, int out_size, void* d_ws, size_t ws_size,
                              hipStream_t stream) {
  Params p;
  memset(&p, 0, sizeof(p));
  p.x = (const float*)d_in[0]; p.mem = (const float*)d_in[1]; p.pos = (const int*)d_in[2];
  p.attn_norm = (const float*)d_in[3]; p.w_in = (const float*)d_in[4]; p.moba_g = (const float*)d_in[5];
  p.diff_g = (const float*)d_in[6]; p.diff_lam = (const float*)d_in[7]; p.diff_subln = (const float*)d_in[8];
  p.dsa_g = (const float*)d_in[9]; p.w_out = (const float*)d_in[10]; p.cross_norm = (const float*)d_in[11];
  p.mem_norm = (const float*)d_in[12]; p.cross_wq = (const float*)d_in[13]; p.cross_wkv = (const float*)d_in[14];
  p.cross_g = (const float*)d_in[15]; p.cross_wo = (const float*)d_in[16]; p.ffn_norm = (const float*)d_in[17];
  p.w_up = (const float*)d_in[18]; p.conv_w = (const float*)d_in[19]; p.conv_b = (const float*)d_in[20];
  p.w_down = (const float*)d_in[21];
  p.out = (float*)d_out;
  unsigned char* w = (unsigned char*)d_ws;
  size_t off = 0;
  auto take = [&](size_t bytes) { unsigned char* r = w + off; off += alignup(bytes); return r; };
  p.counters = (int*)take(10240);
  p.bar = (unsigned*)take((size_t)(XCD_BAR_WORDS + 2048) * 4);
  p.wt_in = (u16*)take((size_t)DINP * D_ * 2);
  p.wt_out = (u16*)take((size_t)D_ * D_ * 2);
  p.wt_cq = (u16*)take((size_t)512 * D_ * 2);
  p.wt_ckv = (u16*)take((size_t)1024 * D_ * 2);
  p.wt_co = (u16*)take((size_t)D_ * 512 * 2);
  p.wt_up = (u16*)take((size_t)DFF2 * D_ * 2);
  p.wt_down = (u16*)take((size_t)D_ * DFF * 2);
  p.ck = (u16*)take((size_t)MEML * 512 * 2);
  p.cvT = (u16*)take((size_t)4 * 128 * MEML * 2);
  p.mnorm = (u16*)take((size_t)MEML * D_ * 2);
  p.kbar = (float*)take((size_t)32 * 768 * 4);
  p.iw = (float*)take((size_t)S_ * 8 * 4);
  p.cq = (u16*)take((size_t)S_ * 512 * 2);
  p.co = (u16*)take((size_t)S_ * 512 * 2);
  const size_t ubase = off;
  p.proj = (u16*)take((size_t)S_ * DIN * 2);
  p.vT = (u16*)take((size_t)16 * 128 * S_ * 2);
  p.mixed = (u16*)take((size_t)S_ * D_ * 2);
  p.dmask = (u32*)take((size_t)S_ * 256 * 4);
  p.dscr = (float*)take((size_t)8 * S_ * 128 * 4);
  p.scores = (u32*)take((size_t)SEL_BLOCKS * 16 * 8192 * 4);
  p.hbuf = (u16*)p.scores;
  const size_t total = off;
  p.ubuf = (u16*)(w + ubase);
  p.act = (u16*)(w + ubase + alignup((size_t)S_ * DFF2 * 2));
  const size_t ubuf_end = ubase + alignup((size_t)S_ * DFF2 * 2);
  const size_t ffn_end = ubuf_end + alignup((size_t)S_ * DFF * 2);
  if ((size_t)((unsigned char*)p.hbuf - w) < ubuf_end || ffn_end > total || total > ws_size) {
    fprintf(stderr, "workspace layout problem: total %zu ws %zu\n", total, ws_size);
    return;
  }
  for (int i = 0; i < 64; ++i) p.inv128[i] = (float)pow(10000.0, -(double)(2 * i) / 128.0);
  for (int i = 0; i < 32; ++i) p.inv64[i] = (float)pow(10000.0, -(double)(2 * i) / 64.0);

  (void)hipMemsetAsync(p.counters, 0, 10240 + (size_t)XCD_BAR_WORDS * 4, stream);
#if MULTI
  const int grid = 512;
  for (int layer = 0; layer < 2; ++layer) {
    phase_kernel<PH_PREP><<<grid, NTHR, 0, stream>>>(p, layer);
    phase_kernel<PH_WIN><<<grid, NTHR, 0, stream>>>(p, layer);
    phase_kernel<PH_MIX1><<<grid, NTHR, 0, stream>>>(p, layer);
    phase_kernel<PH_MIX2><<<grid, NTHR, 0, stream>>>(p, layer);
    phase_kernel<PH_WOUT><<<grid, NTHR, 0, stream>>>(p, layer);
    phase_kernel<PH_NORM2><<<grid, NTHR, 0, stream>>>(p, layer);
    phase_kernel<PH_CQ><<<grid, NTHR, 0, stream>>>(p, layer);
    phase_kernel<PH_CROSS><<<grid, NTHR, 0, stream>>>(p, layer);
    phase_kernel<PH_CO><<<grid, NTHR, 0, stream>>>(p, layer);
    phase_kernel<PH_NORM3><<<grid, NTHR, 0, stream>>>(p, layer);
    phase_kernel<PH_UP><<<grid, NTHR, 0, stream>>>(p, layer);
    phase_kernel<PH_CONV><<<grid, NTHR, 0, stream>>>(p, layer);
    phase_kernel<PH_DOWN><<<grid, NTHR, 0, stream>>>(p, layer);
  }
#else
  static int grid_blocks = 0;
  if (!grid_blocks) {
    int dev = 0, cus = 0, per_cu = 0;
    hipGetDevice(&dev);
    hipDeviceGetAttribute(&cus, hipDeviceAttributeMultiprocessorCount, dev);
    hipOccupancyMaxActiveBlocksPerMultiprocessor(&per_cu, mega_kernel, NTHR, 0);
    if (per_cu > 2) per_cu = 2;
    grid_blocks = cus * per_cu;
  }
  void* args[] = {&p};
  hipError_t e = hipLaunchCooperativeKernel((void*)mega_kernel, dim3(grid_blocks), dim3(NTHR), args, 0, stream);
  if (e != hipSuccess) fprintf(stderr, "cooperative launch failed: %s (grid %d)\n", hipGetErrorString(e), grid_blocks);
#endif
}
```
